# Optimizing an MI355X kernel written in HIP

```python
import jax, jax.numpy as jnp
from jax import lax
import numpy as np

D_MODEL = 2048
BATCH = 8
SEQ = 2048
DEPTH = 1

HEAD_DIM = 64
MIX_WIDTH = D_MODEL
N_HEADS_A = MIX_WIDTH // HEAD_DIM // 2
GQA_RATIO = 8
N_KV_A = N_HEADS_A // GQA_RATIO
GROUP_A = N_HEADS_A // N_KV_A
N_HEADS_B = MIX_WIDTH // HEAD_DIM - N_HEADS_A
WIDTH_A = N_HEADS_A * HEAD_DIM
WIDTH_KV_A = N_KV_A * HEAD_DIM
WIDTH_B = N_HEADS_B * HEAD_DIM
IN_SPLITS = (WIDTH_A, WIDTH_A + WIDTH_KV_A, WIDTH_A + 2 * WIDTH_KV_A, WIDTH_A + 2 * WIDTH_KV_A + WIDTH_B, WIDTH_A + 2 * WIDTH_KV_A + 2 * WIDTH_B)
IN_WIDTH = WIDTH_A + 2 * WIDTH_KV_A + 3 * WIDTH_B
WINDOW_A = 128
DILATED = ((128, 1), (512, 4), (2048, 16))
BLOCK = 128
ROPE_THETA = 500000.0
ROT_DIM = HEAD_DIM // 4
D_FF = 256 * ((8 * D_MODEL // 3 + 255) // 256)
FFN_RES = 0.5
N_SUB = 3
N_MOD = 3
EPS = 1e-5
MAX_START = 4096

kernel_name = 'hybrid_swa_sink_dilated_macaron'


def rmsnorm(x, g):
    xf = x.astype(jnp.float32)
    y = xf * lax.rsqrt(jnp.mean(xf * xf, axis=-1, keepdims=True) + EPS)
    return (y * g.astype(jnp.float32)).astype(x.dtype)


def modulate(h, shift, scale):
    return h * (1 + scale) + shift


def swiglu(h, w_gu, w_down):
    gate, up = jnp.split(h @ w_gu, 2, axis=-1)
    return (jax.nn.silu(gate) * up) @ w_down


def rope_tables(positions):
    inv_freq = ROPE_THETA ** (-(jnp.arange(0, ROT_DIM, 2, dtype=jnp.float32) / ROT_DIM))
    ang = positions.astype(jnp.float32)[..., None] * inv_freq
    return jnp.cos(ang)[:, :, None, :], jnp.sin(ang)[:, :, None, :]


def partial_rope(x, cos, sin):
    xr, xp = x[..., :ROT_DIM], x[..., ROT_DIM:]
    x1, x2 = xr[..., :ROT_DIM // 2], xr[..., ROT_DIM // 2:]
    rot = jnp.concatenate([x1 * cos - x2 * sin, x2 * cos + x1 * sin], axis=-1)
    return jnp.concatenate([rot.astype(x.dtype), xp], axis=-1)


def banded_attention(q, k, v, max_dist, sink=None):
    b, L, hk, g, hd = q.shape
    n_prev = -(-max_dist // BLOCK)
    nb = -(-L // BLOCK)
    pad = nb * BLOCK - L
    front = n_prev * BLOCK
    kw_len = (n_prev + 1) * BLOCK
    qb = jnp.pad(q, ((0, 0), (0, pad), (0, 0), (0, 0), (0, 0))).reshape(b, nb, BLOCK, hk, g, hd)
    kp = jnp.pad(k, ((0, 0), (front, pad), (0, 0), (0, 0))).reshape(b, nb + n_prev, BLOCK, hk, hd)
    vp = jnp.pad(v, ((0, 0), (front, pad), (0, 0), (0, 0))).reshape(b, nb + n_prev, BLOCK, hk, hd)
    kw = jnp.concatenate([kp[:, j:j + nb] for j in range(n_prev + 1)], axis=2)
    vw = jnp.concatenate([vp[:, j:j + nb] for j in range(n_prev + 1)], axis=2)
    qi = jnp.arange(nb)[:, None, None] * BLOCK + jnp.arange(BLOCK)[None, :, None]
    ki = jnp.arange(nb)[:, None, None] * BLOCK + jnp.arange(kw_len)[None, None, :] - front
    dist = qi - ki
    mask = ((dist >= 0) & (dist <= max_dist) & (ki >= 0))[None, :, None, None]
    s = jnp.einsum('bnqhgd,bnkhd->bnhgqk', qb, kw, preferred_element_type=jnp.float32) * (hd ** -0.5)
    s = jnp.where(mask, s, -jnp.inf)
    m = jnp.max(s, axis=-1, keepdims=True)
    if sink is not None:
        sink_l = sink.astype(jnp.float32).reshape(1, 1, hk, g, 1, 1)
        m = jnp.maximum(m, sink_l)
    p = jnp.exp(s - m)
    l = jnp.sum(p, axis=-1, keepdims=True)
    if sink is not None:
        l = l + jnp.exp(sink_l - m)
    o = jnp.einsum('bnhgqk,bnkhd->bnqhgd', p, vw.astype(jnp.float32))
    o = o / jnp.transpose(l, (0, 1, 4, 2, 3, 5))
    lse = jnp.transpose((m + jnp.log(l))[..., 0], (0, 1, 4, 2, 3))
    o = o.reshape(b, nb * BLOCK, hk, g, hd)[:, :L].astype(q.dtype)
    lse = lse.reshape(b, nb * BLOCK, hk, g)[:, :L]
    return o, lse


def to_residues(t, dil):
    b, s = t.shape[:2]
    rest = t.shape[2:]
    return t.reshape((b, s // dil, dil) + rest).swapaxes(1, 2).reshape((b * dil, s // dil) + rest)


def from_residues(t, dil, b):
    m = t.shape[1]
    rest = t.shape[2:]
    return t.reshape((b, dil, m) + rest).swapaxes(1, 2).reshape((b, dil * m) + rest)


def dilated_mixture(q, k, v):
    b, s, h, hd = q.shape
    outs, lses = [], []
    for window, dil in DILATED:
        o, lse = banded_attention(to_residues(q, dil)[:, :, :, None, :], to_residues(k, dil), to_residues(v, dil), window // dil)
        outs.append(from_residues(o[:, :, :, 0, :], dil, b))
        lses.append(from_residues(lse[..., 0], dil, b))
    w = jax.nn.softmax(jnp.stack(lses, axis=0), axis=0)
    out = jnp.sum(w[..., None] * jnp.stack(outs, axis=0).astype(jnp.float32), axis=0)
    return out.reshape(b, s, h * hd).astype(q.dtype)


def hybrid_mixer(h, cos, sin, w_in, b_in, sinks, g_out_a, g_out_b, w_out, b_out):
    b, s, _ = h.shape
    proj = h @ w_in + b_in
    qa, ka, va, qb, kb, vb = jnp.split(proj, IN_SPLITS, axis=-1)
    qa = partial_rope(qa.reshape(b, s, N_HEADS_A, HEAD_DIM), cos, sin).reshape(b, s, N_KV_A, GROUP_A, HEAD_DIM)
    ka = partial_rope(ka.reshape(b, s, N_KV_A, HEAD_DIM), cos, sin)
    va = va.reshape(b, s, N_KV_A, HEAD_DIM)
    out_a, _ = banded_attention(qa, ka, va, WINDOW_A - 1, sinks.reshape(N_KV_A, GROUP_A))
    out_a = out_a.reshape(b, s, WIDTH_A)
    qb = partial_rope(qb.reshape(b, s, N_HEADS_B, HEAD_DIM), cos, sin)
    kb = partial_rope(kb.reshape(b, s, N_HEADS_B, HEAD_DIM), cos, sin)
    vb = vb.reshape(b, s, N_HEADS_B, HEAD_DIM)
    out_b = dilated_mixture(qb, kb, vb)
    y = jnp.concatenate([rmsnorm(out_a, g_out_a), rmsnorm(out_b, g_out_b)], axis=-1)
    return y @ w_out + b_out


def setup_inputs(seed: int = 0) -> dict:
    key = jax.random.key(seed)
    ks = jax.random.split(key, 20)
    nrm = jax.random.normal
    f32 = jnp.float32
    x = nrm(ks[0], (BATCH, SEQ, D_MODEL), f32)
    c = nrm(ks[1], (BATCH, D_MODEL), f32)
    start = jax.random.randint(ks[2], (BATCH, 1), 0, MAX_START, dtype=jnp.int32)
    positions = start + jnp.arange(SEQ, dtype=jnp.int32)[None, :]
    w_ada = nrm(ks[3], (DEPTH, D_MODEL, N_SUB * N_MOD * D_MODEL), f32) * D_MODEL ** -0.5
    b_ada = 0.02 * nrm(ks[4], (DEPTH, N_SUB * N_MOD * D_MODEL), f32)
    g_ffn1 = 1.0 + 0.02 * nrm(ks[5], (DEPTH, D_MODEL), f32)
    w_ffn1_in = nrm(ks[6], (DEPTH, D_MODEL, 2 * D_FF), f32) * D_MODEL ** -0.5
    w_ffn1_out = nrm(ks[7], (DEPTH, D_FF, D_MODEL), f32) * D_FF ** -0.5
    g_mix = 1.0 + 0.02 * nrm(ks[8], (DEPTH, D_MODEL), f32)
    w_in = nrm(ks[9], (DEPTH, D_MODEL, IN_WIDTH), f32) * D_MODEL ** -0.5
    b_in = 0.02 * nrm(ks[10], (DEPTH, IN_WIDTH), f32)
    sinks = nrm(ks[11], (DEPTH, N_HEADS_A), f32)
    g_out_a = 1.0 + 0.02 * nrm(ks[12], (DEPTH, WIDTH_A), f32)
    g_out_b = 1.0 + 0.02 * nrm(ks[13], (DEPTH, WIDTH_B), f32)
    w_out = nrm(ks[14], (DEPTH, MIX_WIDTH, D_MODEL), f32) * MIX_WIDTH ** -0.5
    b_out = 0.02 * nrm(ks[15], (DEPTH, D_MODEL), f32)
    g_ffn2 = 1.0 + 0.02 * nrm(ks[16], (DEPTH, D_MODEL), f32)
    w_ffn2_in = nrm(ks[17], (DEPTH, D_MODEL, 2 * D_FF), f32) * D_MODEL ** -0.5
    w_ffn2_out = nrm(ks[18], (DEPTH, D_FF, D_MODEL), f32) * D_FF ** -0.5
    g_final = 1.0 + 0.02 * nrm(ks[19], (D_MODEL,), f32)
    return {'x': x, 'c': c, 'positions': positions, 'w_ada': w_ada, 'b_ada': b_ada,
            'g_ffn1': g_ffn1, 'w_ffn1_in': w_ffn1_in, 'w_ffn1_out': w_ffn1_out,
            'g_mix': g_mix, 'w_in': w_in, 'b_in': b_in, 'sinks': sinks,
            'g_out_a': g_out_a, 'g_out_b': g_out_b, 'w_out': w_out, 'b_out': b_out,
            'g_ffn2': g_ffn2, 'w_ffn2_in': w_ffn2_in, 'w_ffn2_out': w_ffn2_out, 'g_final': g_final}


def reference(x, c, positions, w_ada, b_ada, g_ffn1, w_ffn1_in, w_ffn1_out, g_mix, w_in, b_in, sinks, g_out_a, g_out_b, w_out, b_out, g_ffn2, w_ffn2_in, w_ffn2_out, g_final):
    b = x.shape[0]
    cos, sin = rope_tables(positions)
    cond = jax.nn.silu(c)
    for layer in range(DEPTH):
        mod = (cond @ w_ada[layer] + b_ada[layer]).reshape(b, N_SUB, N_MOD, D_MODEL)
        shift = mod[:, :, 0, None, :]
        scale = mod[:, :, 1, None, :]
        gate = mod[:, :, 2, None, :]
        h = modulate(rmsnorm(x, g_ffn1[layer]), shift[:, 0], scale[:, 0])
        x = x + FFN_RES * gate[:, 0] * swiglu(h, w_ffn1_in[layer], w_ffn1_out[layer])
        h = modulate(rmsnorm(x, g_mix[layer]), shift[:, 1], scale[:, 1])
        x = x + gate[:, 1] * hybrid_mixer(h, cos, sin, w_in[layer], b_in[layer], sinks[layer], g_out_a[layer], g_out_b[layer], w_out[layer], b_out[layer])
        h = modulate(rmsnorm(x, g_ffn2[layer]), shift[:, 2], scale[:, 2])
        x = x + FFN_RES * gate[:, 2] * swiglu(h, w_ffn2_in[layer], w_ffn2_out[layer])
    return rmsnorm(x, g_final)
```

```cpp
#include <hip/hip_runtime.h>
#include <hip/hip_cooperative_groups.h>
#include <cstdio>
#include <cstdint>
#include <cmath>
namespace cg = cooperative_groups;
#ifndef MK_MULTI
#define MK_MULTI 0
#ifndef GEMM_ALIGN
#define GEMM_ALIGN true
#endif
#ifndef GEMM_SP2
#define GEMM_SP2 true
#endif
#endif
namespace pg8 {
#define PG8_LAS __attribute__((address_space(3)))
typedef unsigned short bf16_t;
typedef short bf16x8 __attribute__((ext_vector_type(8)));
typedef float f32x4 __attribute__((ext_vector_type(4)));
typedef unsigned u32x4 __attribute__((ext_vector_type(4)));
constexpr int BM = 256, BK = 64, HALF = 128, HTB = HALF * BK * 2  , STAGE_BYTES = 8 * HTB, NXCD = 8, WGM = 8;

__host__ __device__ __forceinline__ int lds_byte(int r, int c) { const int st = (r >> 4) * 2 + (c >> 5), rr = r & 15, cc = c & 31, ob = rr * 64 + cc * 2; return st * 1024 + (ob ^ (((ob >> 9) & 1) << 5)); }
__host__ __device__ __forceinline__ void stage_rc(int b, int& R, int& C) { const int st = b / 1024, sb = b % 1024, swz = sb ^ (((sb >> 9) & 1) << 5); R = (st >> 1) * 16 + swz / 64; C = (st & 1) * 32 + (swz % 64) / 2; }
__host__ __device__ __forceinline__ int perm32(int rho) { const int n = rho >> 4, i = rho & 15; return 8 * (i >> 2) + 4 * n + (i & 3); }

struct Unit { int pm, pn; };
struct Gemm { const bf16_t* A; const bf16_t* Bt; int M, N, K; };

struct StaticOrder {
    int nM, nN, nwg, G, c;
    __host__ __device__ void init(int M, int N, int G_, int c_) { nM = M / BM; nN = N / BM; nwg = nM * nN; G = G_; c = c_; }
    __host__ __device__ bool next(int i, Unit& u) const {
        const long L = (long)i * G + c; if (L >= nwg) return false;
        int wgid = (int)L; { const int q = nwg / NXCD, r = nwg % NXCD, xcd = wgid % NXCD, off = wgid / NXCD; wgid = (xcd < r ? xcd * (q + 1) : r * (q + 1) + (xcd - r) * q) + off; }
        const int nig = WGM * nN, gid = wgid / nig, fm = gid * WGM, gsz = (nM - fm) < WGM ? (nM - fm) : WGM;
        u.pm = fm + ((wgid % nig) % gsz); u.pn = (wgid % nig) / gsz; return true;
    }
    __device__ __forceinline__ void a_ready(const Unit&) const {}
    __device__ __forceinline__ void done(const Unit&) const {}
};

typedef float f32x2_t __attribute__((ext_vector_type(2))); typedef __bf16 bf16x2_t __attribute__((ext_vector_type(2)));
__device__ __forceinline__ unsigned cvt_pk_bf16(float lo, float hi) { f32x2_t v = {lo, hi}; bf16x2_t b = __builtin_convertvector(v, bf16x2_t); return __builtin_bit_cast(unsigned, b); }
__device__ __forceinline__ float silu_mul(float g, float u) { return g * u * __builtin_amdgcn_rcpf(1.0f + __builtin_amdgcn_exp2f(-1.4426950408889634f * g)); }

struct EpiSwiglu {
    static constexpr bool PERM = true, AFTER_DRAIN = false;
    bf16_t* O; int ldo;
    __device__ __forceinline__ void operator()(const f32x4 (&acc)[2][2][4][2], const Unit& u, int wr, int wc, int fr, int fq) const {
        const int row0 = u.pm * BM + wr * 64 + fr, col0 = u.pn * HALF + wc * 32 + 8 * fq;
#ifdef PROBE_SWEPI2
      for (int rp_ = 0; rp_ < 2; ++rp_) { asm volatile("" ::: "memory");
#endif
#pragma unroll
        for (int ai = 0; ai < 2; ++ai)
#pragma unroll
            for (int m = 0; m < 4; ++m) {
                bf16_t* p = O + (size_t)(row0 + ai * HALF + m * 16) * ldo + col0;
                const f32x4 g0 = acc[ai][0][m][0], g1 = acc[ai][0][m][1], u0 = acc[ai][1][m][0], u1 = acc[ai][1][m][1];
                u32x4 w;
                w.x = cvt_pk_bf16(silu_mul(g0[0], u0[0]), silu_mul(g0[1], u0[1]));
                w.y = cvt_pk_bf16(silu_mul(g0[2], u0[2]), silu_mul(g0[3], u0[3]));
                w.z = cvt_pk_bf16(silu_mul(g1[0], u1[0]), silu_mul(g1[1], u1[1]));
                w.w = cvt_pk_bf16(silu_mul(g1[2], u1[2]), silu_mul(g1[3], u1[3]));
                *(u32x4*)p = w;
            }
#ifdef PROBE_SWEPI2
      }
#endif
    }
};

template <bool BASE_BF16> struct EpiResid {
    static constexpr bool PERM = true, AFTER_DRAIN = false;
    const void* base; bf16_t* out; const float* bias; const float* gatev; float gs; int ldc, gstride;
    __device__ __forceinline__ void operator()(const f32x4 (&acc)[2][2][4][2], const Unit& u, int wr, int wc, int fr, int fq) const {
        const float* gp = gatev + (size_t)(u.pm >> 3) * gstride;
        const int row0 = u.pm * BM + wr * 64 + fr;
#pragma unroll
        for (int bj = 0; bj < 2; ++bj) {
            const int col0 = u.pn * BM + bj * HALF + wc * 32 + 8 * fq;
            const f32x4 g0 = *(const f32x4*)(gp + col0) * gs, g1 = *(const f32x4*)(gp + col0 + 4) * gs;
            const f32x4 b0 = bias ? *(const f32x4*)(bias + col0) : (f32x4){0.f, 0.f, 0.f, 0.f}, b1 = bias ? *(const f32x4*)(bias + col0 + 4) : (f32x4){0.f, 0.f, 0.f, 0.f};
#pragma unroll
            for (int ai = 0; ai < 2; ++ai)
#pragma unroll
                for (int m = 0; m < 4; ++m) {
                    const size_t off = (size_t)(row0 + ai * HALF + m * 16) * ldc + col0;
                    f32x4 s0, s1;
                    if (BASE_BF16) { const u32x4 w = *(const u32x4*)((const bf16_t*)base + off);
                        s0 = (f32x4){__uint_as_float(w.x << 16), __uint_as_float(w.x & 0xffff0000u), __uint_as_float(w.y << 16), __uint_as_float(w.y & 0xffff0000u)};
                        s1 = (f32x4){__uint_as_float(w.z << 16), __uint_as_float(w.z & 0xffff0000u), __uint_as_float(w.w << 16), __uint_as_float(w.w & 0xffff0000u)}; }
                    else { s0 = *(const f32x4*)((const float*)base + off); s1 = *(const f32x4*)((const float*)base + off + 4); }
                    const f32x4 v0 = s0 + g0 * (acc[ai][bj][m][0] + b0), v1 = s1 + g1 * (acc[ai][bj][m][1] + b1);
                    u32x4 w; w.x = cvt_pk_bf16(v0[0], v0[1]); w.y = cvt_pk_bf16(v0[2], v0[3]); w.z = cvt_pk_bf16(v1[0], v1[1]); w.w = cvt_pk_bf16(v1[2], v1[3]);
                    *(u32x4*)(out + off) = w;
                }
        }
    }
};

struct EpiQKV {
    static constexpr bool PERM = true, AFTER_DRAIN = false;
    bf16_t* O; const float* bias; const float* rope; int ldo;
    __device__ __forceinline__ void operator()(const f32x4 (&acc)[2][2][4][2], const Unit& u, int wr, int wc, int fr, int fq) const {
        const int row0 = u.pm * BM + wr * 64 + fr;
#pragma unroll
        for (int bj = 0; bj < 2; ++bj) {
            const int ch = u.pn * BM + bj * HALF;
            const bool rope_on = ((ch < 1152) || (ch >= 1280 && ch < 3328)) && ((wc & 1) == 0);
            const int col0 = ch + wc * 32 + 8 * fq;
            const f32x4 b0 = *(const f32x4*)(bias + col0), b1 = *(const f32x4*)(bias + col0 + 4);
#pragma unroll
            for (int ai = 0; ai < 2; ++ai)
#pragma unroll
                for (int m = 0; m < 4; ++m) {
                    const int row = row0 + ai * HALF + m * 16;
                    f32x4 x0 = acc[ai][bj][m][0] + b0, x1 = acc[ai][bj][m][1] + b1;
                    if (rope_on) {
                        f32x4 y0, y1;
#pragma unroll
                        for (int i = 0; i < 4; ++i) { y0[i] = __shfl_xor(x0[i], 16); y1[i] = __shfl_xor(x1[i], 16); }
                        if (fq < 2) {
                            const float* rp = rope + (size_t)row * 16;
                            const f32x4 c0 = *(const f32x4*)(rp), c1 = *(const f32x4*)(rp + 4), s0 = *(const f32x4*)(rp + 8), s1 = *(const f32x4*)(rp + 12);
                            if (fq == 0) { x0 = x0 * c0 - y0 * s0; x1 = x1 * c1 - y1 * s1; }
                            else         { x0 = x0 * c0 + y0 * s0; x1 = x1 * c1 + y1 * s1; }
                        }
                    }
                    u32x4 w; w.x = cvt_pk_bf16(x0[0], x0[1]); w.y = cvt_pk_bf16(x0[2], x0[3]); w.z = cvt_pk_bf16(x1[0], x1[1]); w.w = cvt_pk_bf16(x1[2], x1[3]);
                    *(u32x4*)(O + (size_t)row * ldo + col0) = w;
                }
        }
    }
};

template <class Epi, class Sched, bool ALIGN_EPI = false, bool SP2 = false>
__device__ __forceinline__ void gemm_phase(PG8_LAS unsigned char* lds, const Gemm g, const Sched& S, const Epi& E) {
    const int tid = threadIdx.x, wid = __builtin_amdgcn_readfirstlane(tid >> 6), lane = tid & 63, wr = wid >> 2, wc = wid & 3, fr = lane & 15, fq = lane >> 4;
    const int K = g.K, nt = K / BK;
    unsigned voffA[2], voffB[2];
#pragma unroll
    for (int i = 0; i < 2; ++i) { int R, C; stage_rc(tid * 16 + i * 8192, R, C); const int Rb = Epi::PERM ? ((R & ~31) + perm32(R & 31)) : R;
        voffA[i] = (unsigned)(R * K + C) * 2u; voffB[i] = (unsigned)(Rb * K + C) * 2u; }
    const size_t kstep = (size_t)(BK * 2);
    const size_t hstep = (size_t)HALF * K * 2;
    const size_t tstep = 2 * hstep;
    const unsigned ldsw = (unsigned)wid * 1024u;
    const int aoff = lds_byte(wr * 64 + fr, fq * 8), boff = lds_byte(wc * 32 + fr, fq * 8);
#define PG8_SA(b, h) (((b) * 2 + (h)) * HTB)
#define PG8_SB(b, h) ((4 + (b) * 2 + (h)) * HTB)
#define PG8_STAGE(bufoff, gbase, voff) do { _Pragma("unroll") for (int _i = 0; _i < 2; ++_i) \
        __builtin_amdgcn_global_load_lds((const unsigned*)((const char*)(gbase) + (voff)[_i]), (PG8_LAS unsigned*)(lds + (bufoff) + ldsw + _i * 8192), 16, 0, 0); } while (0)
#define PG8_LDA(dst, b, h) do { _Pragma("unroll") for (int m = 0; m < 4; ++m) _Pragma("unroll") for (int k = 0; k < 2; ++k) dst[m][k] = *(const PG8_LAS bf16x8*)(lds + PG8_SA(b, h) + aoff + m * 2048 + k * 1024); } while (0)
#define PG8_LDB(dst, b, h) do { _Pragma("unroll") for (int n = 0; n < 2; ++n) _Pragma("unroll") for (int k = 0; k < 2; ++k) dst[n][k] = *(const PG8_LAS bf16x8*)(lds + PG8_SB(b, h) + boff + n * 2048 + k * 1024); } while (0)
#define PG8_MMA(ai, bj, At, Bt) do { __builtin_amdgcn_s_setprio(1); _Pragma("unroll") for (int m = 0; m < 4; ++m) _Pragma("unroll") for (int n = 0; n < 2; ++n) _Pragma("unroll") for (int k = 0; k < 2; ++k) \
        acc[ai][bj][m][n] = __builtin_amdgcn_mfma_f32_16x16x32_bf16(Bt[n][k], At[m][k], acc[ai][bj][m][n], 0, 0, 0); __builtin_amdgcn_s_setprio(0); } while (0)
#define PG8_WAIT_V(n) asm volatile("s_waitcnt vmcnt(" #n ")" ::: "memory")
#define PG8_WAIT_L(n) asm volatile("s_waitcnt lgkmcnt(" #n ")" ::: "memory")
#define PG8_BAR __builtin_amdgcn_s_barrier()
#define PG8_SCHED __builtin_amdgcn_sched_barrier(0)
    Unit cur, nxt; int ui = 0;
    if (!S.next(0, cur)) return;
    f32x4 acc[2][2][4][2];
#pragma unroll
    for (int a = 0; a < 2; ++a)
#pragma unroll
        for (int b = 0; b < 2; ++b)
#pragma unroll
            for (int m = 0; m < 4; ++m)
#pragma unroll
                for (int n = 0; n < 2; ++n) acc[a][b][m][n] = (f32x4){0.f, 0.f, 0.f, 0.f};
    bf16x8 At[4][2], B0[2][2], B1[2][2];
    const char* cA = (const char*)g.A + (size_t)cur.pm * tstep; const char* cB = (const char*)g.Bt + (size_t)cur.pn * tstep;
    S.a_ready(cur);
    if constexpr (SP2) {
        PG8_STAGE(PG8_SB(0, 0), cB, voffB); PG8_STAGE(PG8_SB(0, 1), cB + hstep, voffB); PG8_STAGE(PG8_SA(0, 0), cA, voffA); PG8_STAGE(PG8_SA(0, 1), cA + hstep, voffA);
        if (wr == 1) PG8_BAR;
        PG8_WAIT_V(2); PG8_BAR;
        PG8_STAGE(PG8_SB(1, 0), cB + kstep, voffB); PG8_STAGE(PG8_SA(1, 0), cA + kstep, voffA); PG8_STAGE(PG8_SB(1, 1), cB + hstep + kstep, voffB);
        PG8_WAIT_V(6); PG8_BAR;
    } else {
        PG8_STAGE(PG8_SB(0, 0), cB, voffB); PG8_STAGE(PG8_SA(0, 0), cA, voffA); PG8_STAGE(PG8_SB(0, 1), cB + hstep, voffB); PG8_STAGE(PG8_SA(0, 1), cA + hstep, voffA);
        if (wr == 1) PG8_BAR;
        PG8_WAIT_V(4); PG8_BAR;
        PG8_STAGE(PG8_SB(1, 0), cB + kstep, voffB); PG8_STAGE(PG8_SA(1, 0), cA + kstep, voffA); PG8_STAGE(PG8_SB(1, 1), cB + hstep + kstep, voffB);
        PG8_WAIT_V(6); PG8_BAR;
    }
    for (;;) {
        const bool has_next = S.next(ui + 1, nxt);
        const char* nA = has_next ? (const char*)g.A + (size_t)nxt.pm * tstep : cA; const char* nB = has_next ? (const char*)g.Bt + (size_t)nxt.pn * tstep : cB;
        for (int t = 0; t < nt; t += 2) {
            const bool last = (t == nt - 2);
            const char* a1 = cA + (size_t)(t + 1) * kstep;
            const char* a2 = last ? nA : cA + (size_t)(t + 2) * kstep; const char* b2 = last ? nB : cB + (size_t)(t + 2) * kstep;
            const char* a3 = a2 + kstep; const char* b3 = b2 + kstep;
            if (last && has_next) S.a_ready(nxt);
            if constexpr (SP2) {
            PG8_LDB(B0, 0, 0); PG8_LDB(B1, 0, 1); PG8_SCHED; PG8_LDA(At, 0, 0); PG8_STAGE(PG8_SA(1, 1), a1 + hstep, voffA);
            PG8_WAIT_V(8); PG8_WAIT_L(0); PG8_BAR; PG8_MMA(0, 0, At, B0); PG8_MMA(0, 1, At, B1); PG8_BAR; PG8_SCHED;
            PG8_LDA(At, 0, 1); PG8_STAGE(PG8_SB(0, 0), b2, voffB); PG8_STAGE(PG8_SB(0, 1), b2 + hstep, voffB); PG8_STAGE(PG8_SA(0, 0), a2, voffA);
            PG8_WAIT_V(8); PG8_WAIT_L(0); PG8_BAR; PG8_MMA(1, 0, At, B0); PG8_MMA(1, 1, At, B1); PG8_BAR; PG8_SCHED;
            PG8_LDB(B0, 1, 0); PG8_LDB(B1, 1, 1); PG8_SCHED; PG8_LDA(At, 1, 0); PG8_STAGE(PG8_SA(0, 1), a2 + hstep, voffA);
            PG8_WAIT_V(8); PG8_WAIT_L(0); PG8_BAR; PG8_MMA(0, 0, At, B0); PG8_MMA(0, 1, At, B1); PG8_BAR; PG8_SCHED;
            PG8_LDA(At, 1, 1); PG8_STAGE(PG8_SB(1, 0), b3, voffB); PG8_STAGE(PG8_SB(1, 1), b3 + hstep, voffB); PG8_STAGE(PG8_SA(1, 0), a3, voffA);
            PG8_WAIT_V(8); PG8_WAIT_L(0); PG8_BAR; PG8_MMA(1, 0, At, B0); PG8_MMA(1, 1, At, B1); PG8_BAR; PG8_SCHED;
            } else {
            PG8_LDB(B0, 0, 0); PG8_SCHED; PG8_LDA(At, 0, 0); PG8_STAGE(PG8_SA(1, 1), a1 + hstep, voffA);
            PG8_WAIT_L(8); PG8_BAR; PG8_WAIT_L(0); PG8_MMA(0, 0, At, B0); PG8_BAR; PG8_SCHED;
            PG8_LDB(B1, 0, 1); PG8_STAGE(PG8_SB(0, 0), b2, voffB);
            PG8_BAR; PG8_WAIT_L(0); PG8_MMA(0, 1, At, B1); PG8_BAR;
            PG8_LDA(At, 0, 1); PG8_STAGE(PG8_SA(0, 0), a2, voffA);
            PG8_BAR; PG8_WAIT_L(0); PG8_MMA(1, 0, At, B0); PG8_BAR; PG8_SCHED;
            PG8_STAGE(PG8_SB(0, 1), b2 + hstep, voffB);
            PG8_WAIT_V(6); PG8_BAR; PG8_MMA(1, 1, At, B1); PG8_BAR;
            PG8_LDB(B0, 1, 0); PG8_SCHED; PG8_LDA(At, 1, 0); PG8_STAGE(PG8_SA(0, 1), a2 + hstep, voffA);
            PG8_WAIT_L(8); PG8_BAR; PG8_WAIT_L(0); PG8_MMA(0, 0, At, B0); PG8_BAR; PG8_SCHED;
            PG8_LDB(B1, 1, 1); PG8_STAGE(PG8_SB(1, 0), b3, voffB);
            PG8_BAR; PG8_WAIT_L(0); PG8_MMA(0, 1, At, B1); PG8_BAR;
            PG8_LDA(At, 1, 1); PG8_STAGE(PG8_SA(1, 0), a3, voffA);
            PG8_BAR; PG8_WAIT_L(0); PG8_MMA(1, 0, At, B0); PG8_BAR; PG8_SCHED;
            PG8_STAGE(PG8_SB(1, 1), b3 + hstep, voffB);
            PG8_WAIT_V(6); PG8_BAR; PG8_MMA(1, 1, At, B1); PG8_BAR;
            }
        }
        if constexpr (ALIGN_EPI) { if (wr == 0) PG8_BAR; }
        if constexpr (!Epi::AFTER_DRAIN) { E(acc, cur, wr, wc, fr, fq); S.done(cur); }
        if (!has_next) break;
#pragma unroll
        for (int a = 0; a < 2; ++a)
#pragma unroll
            for (int b = 0; b < 2; ++b)
#pragma unroll
                for (int m = 0; m < 4; ++m)
#pragma unroll
                    for (int n = 0; n < 2; ++n) acc[a][b][m][n] = (f32x4){0.f, 0.f, 0.f, 0.f};
        cur = nxt; cA = nA; cB = nB; ++ui;
        if constexpr (ALIGN_EPI) { if (wr == 1) PG8_BAR; }
    }
    PG8_WAIT_V(0);
    if constexpr (!ALIGN_EPI) { if (wr == 0) PG8_BAR; }
    PG8_BAR;
    if constexpr (Epi::AFTER_DRAIN) { E.fused(acc, cur, wr, wc, fr, fq, lds, wid, lane); S.done(cur); }
#undef PG8_SA
#undef PG8_SB
#undef PG8_STAGE
#undef PG8_LDA
#undef PG8_LDB
#undef PG8_MMA
#undef PG8_WAIT_V
#undef PG8_WAIT_L
#undef PG8_BAR
#undef PG8_SCHED
}
}

constexpr int NB = 8, SEQ = 2048, T = NB * SEQ, D = 2048, FF = 5632, NIN = 4352, NMOD = 9 * D;
constexpr float EPS = 1e-5f;
constexpr size_t MiB = 1u << 20;
constexpr size_t WS_WGU1 = 0, WS_WD1 = 44 * MiB, WS_WIN = 66 * MiB, WS_WOUT = 83 * MiB, WS_WGU2 = 91 * MiB, WS_WD2 = 135 * MiB;
constexpr size_t WS_MOD = 157 * MiB, WS_ROPE = 158 * MiB, WS_A = 159 * MiB, WS_R = 223 * MiB;
constexpr size_t WS_U = WS_R;
constexpr size_t WS_PROJ = WS_R, WS_OA = WS_R + 136 * MiB, WS_OB = WS_OA + 32 * MiB, WS_LSE = WS_OB + 96 * MiB, WS_CTL = WS_LSE + 3 * MiB, WS_XB = WS_CTL + 1 * MiB, WS_END = WS_XB + 64 * MiB;
constexpr int LDS_BYTES = 147456, NPH = 13;

#define LAS __attribute__((address_space(3)))
typedef unsigned short bf16;
typedef float f32x4 __attribute__((ext_vector_type(4)));
typedef float f32x16 __attribute__((ext_vector_type(16)));
typedef short bf16x8 __attribute__((ext_vector_type(8)));
typedef short s16x4 __attribute__((ext_vector_type(4)));
typedef unsigned u32x4 __attribute__((ext_vector_type(4)));
typedef unsigned u32x2 __attribute__((ext_vector_type(2)));
using pg8::cvt_pk_bf16;

__device__ __forceinline__ float wave_sum(float v) {
#pragma unroll
    for (int o = 1; o < 64; o <<= 1) v += __shfl_xor(v, o);
    return v;
}
__device__ __forceinline__ float bf_lo(unsigned w) { return __uint_as_float(w << 16); }
__device__ __forceinline__ float bf_hi(unsigned w) { return __uint_as_float(w & 0xffff0000u); }

struct Args { const float* in[20]; float* out; unsigned char* ws; float invf[8]; int ph_lo, ph_hi; };

struct TrItem { const float* W; bf16* WT; int K, N, mode, r; };
__device__ __forceinline__ void tr_load(const TrItem& t, f32x4 (&v)[16], int lane) {
    const int nblk = t.N / 64, kb = t.r / nblk, nb = t.r % nblk, k0 = 64 * kb, n0 = 64 * nb;
#pragma unroll
    for (int i = 0; i < 16; ++i) v[i] = __builtin_nontemporal_load((const f32x4*)(t.W + (size_t)(k0 + 4 * i + (lane >> 4)) * t.N + n0 + (lane & 15) * 4));
}
__device__ __forceinline__ void tr_lds_write(const f32x4 (&v)[16], LAS float* scr, int lane) {
#pragma unroll
    for (int i = 0; i < 16; ++i) { LAS float* s = scr + (4 * i + (lane >> 4)) * 65 + (lane & 15) * 4; s[0] = v[i][0]; s[1] = v[i][1]; s[2] = v[i][2]; s[3] = v[i][3]; }
}
__device__ __forceinline__ void tr_store(const TrItem& t, LAS float* scr, int lane) {
    const int nblk = t.N / 64, kb = t.r / nblk, nb = t.r % nblk, k0 = 64 * kb, n0 = 64 * nb;
    int drow0 = n0;
    if (t.mode == 1) { const int h = n0 >= FF ? 1 : 0, j = n0 - h * FF; drow0 = (j >> 7) * 256 + h * 128 + (j & 127); }
    const int c = lane & 7;
#pragma unroll
    for (int j = 0; j < 8; ++j) {
        const int n = (lane >> 3) + 8 * j; const LAS float* s = scr + (8 * c) * 65 + n;
        u32x4 o; o.x = cvt_pk_bf16(s[0], s[65]); o.y = cvt_pk_bf16(s[2 * 65], s[3 * 65]); o.z = cvt_pk_bf16(s[4 * 65], s[5 * 65]); o.w = cvt_pk_bf16(s[6 * 65], s[7 * 65]);
        *(u32x4*)(t.WT + (size_t)(drow0 + n) * t.K + k0 + 8 * c) = o;
    }
}
__device__ __forceinline__ void transpose_queue(const Args& a, LAS unsigned char* lds, int lane, int wave, int part) {
    unsigned char* ws = a.ws;
    LAS float* scr = (LAS float*)(lds + wave * 16640);
    unsigned* ctr = (unsigned*)(ws + WS_CTL) + 64 * part;
    constexpr int I_GU = (D / 64) * (2 * FF / 64), I_DN = (FF / 64) * (D / 64), I_IN = (D / 64) * (NIN / 64), I_OUT = (D / 64) * (D / 64);
    const int NITEMS = part == 0 ? I_GU + I_DN + I_IN + I_OUT : I_GU + I_DN;
    constexpr int CH = 8;
    static_assert(I_GU % CH == 0 && I_DN % CH == 0 && I_IN % CH == 0 && I_OUT % CH == 0, "chunks");
    auto decode = [&](int r) -> TrItem {
        if (part == 0) {
            if (r < I_GU) return TrItem{a.in[6], (bf16*)(ws + WS_WGU1), D, 2 * FF, 1, r}; r -= I_GU;
            if (r < I_DN) return TrItem{a.in[7], (bf16*)(ws + WS_WD1), FF, D, 0, r}; r -= I_DN;
            if (r < I_IN) return TrItem{a.in[9], (bf16*)(ws + WS_WIN), D, NIN, 0, r}; r -= I_IN;
            return TrItem{a.in[14], (bf16*)(ws + WS_WOUT), D, D, 0, r};
        }
        if (r < I_GU) return TrItem{a.in[17], (bf16*)(ws + WS_WGU2), D, 2 * FF, 1, r}; r -= I_GU;
        return TrItem{a.in[18], (bf16*)(ws + WS_WD2), FF, D, 0, r};
    };
    for (;;) {
        unsigned cidx = 0; if (lane == 0) cidx = atomicAdd(ctr, 1u);
        cidx = __builtin_amdgcn_readfirstlane(cidx);
        if (cidx * CH >= (unsigned)NITEMS) break;
        f32x4 v[16];
        TrItem cur = decode((int)cidx * CH);
        tr_load(cur, v, lane);
#pragma unroll
        for (int q = 0; q < CH; ++q) {
            tr_lds_write(v, scr, lane);
            TrItem nxt = cur;
            if (q + 1 < CH) { nxt = decode((int)cidx * CH + q + 1); tr_load(nxt, v, lane); }
            tr_store(cur, scr, lane);
            cur = nxt;
        }
    }
}

__device__ __forceinline__ void p0_prep(const Args& a, LAS unsigned char* lds, int tid, int lane, int wave, int G, int rep) {
    unsigned char* ws = a.ws;
    if (rep == 0) {
        const int* pos = (const int*)a.in[2]; float* tab = (float*)(ws + WS_ROPE);
        for (int tok = blockIdx.x * 512 + tid; tok < T; tok += G * 512) {
            const float pf = (float)pos[tok];
#pragma unroll
            for (int i = 0; i < 8; ++i) {
                const float ang = pf * a.invf[i];
                double rev = (double)ang * 0.15915494309189535; rev -= floor(rev);
                const float fr = (float)rev;
                tab[tok * 16 + i] = __builtin_amdgcn_cosf(fr); tab[tok * 16 + 8 + i] = __builtin_amdgcn_sinf(fr);
            }
        }
    }
    if (rep == 0) {
        LAS float* scT = (LAS float*)lds;
        LAS float* red = (LAS float*)(lds + 65536);
        const float* cc = a.in[1]; const float* Wa = a.in[3]; const float* ba = a.in[4]; float* mod = (float*)(ws + WS_MOD);
        for (int i = tid; i < NB * D; i += 512) { const int b = i / D, k = i % D; const float x = cc[i]; scT[k * 8 + b] = x / (1.0f + __expf(-x)); }
        __syncthreads();
        for (int it = blockIdx.x; it < NMOD / 64; it += G) {
            const int j = it * 64 + lane; const float* wp = Wa + (size_t)(wave * 256) * NMOD + j;
            float acc[8];
#pragma unroll
            for (int b = 0; b < 8; ++b) acc[b] = 0.f;
            for (int k0 = 0; k0 < 256; k0 += 32) {
                float w[32];
#pragma unroll
                for (int kk = 0; kk < 32; ++kk) w[kk] = __builtin_nontemporal_load(wp + (size_t)(k0 + kk) * NMOD);
#pragma unroll
                for (int kk = 0; kk < 32; ++kk) {
                    const LAS f32x4* sp = (const LAS f32x4*)(scT + (wave * 256 + k0 + kk) * 8);
                    const f32x4 s0 = sp[0], s1 = sp[1];
                    acc[0] += s0[0] * w[kk]; acc[1] += s0[1] * w[kk]; acc[2] += s0[2] * w[kk]; acc[3] += s0[3] * w[kk];
                    acc[4] += s1[0] * w[kk]; acc[5] += s1[1] * w[kk]; acc[6] += s1[2] * w[kk]; acc[7] += s1[3] * w[kk];
                }
            }
#pragma unroll
            for (int b = 0; b < 8; ++b) red[(wave * 8 + b) * 64 + lane] = acc[b];
            __syncthreads();
            { const int b = tid >> 6; float s = 0.f;
#pragma unroll
              for (int w = 0; w < 8; ++w) s += red[(w * 8 + b) * 64 + lane];
              mod[(size_t)b * NMOD + j] = s + ba[j]; }
            __syncthreads();
        }
    }
    __syncthreads();
    __syncthreads();
    transpose_queue(a, lds, lane, wave, 0);
}

template <bool IN_BF16>
__device__ __forceinline__ void norm_phase(const void* Xv, const float* g, const float* mod, int sub, bf16* outb, float* outf, int gw, int NGW, int lane, bf16* xcopy = nullptr) {
    for (int rb = gw; rb < T / 8; rb += NGW) {
        const int b = rb / (SEQ / 8);
        f32x4 A[8], S[8];
#pragma unroll
        for (int j = 0; j < 8; ++j) {
            const int c4 = (64 * j + lane) * 4;
            A[j] = *(const f32x4*)(g + c4);
            if (mod) { const float* mp = mod + (size_t)b * NMOD + (sub * 3) * D + c4; S[j] = *(const f32x4*)(mp); A[j] = A[j] * (*(const f32x4*)(mp + D) + 1.0f); }
            else S[j] = (f32x4){0.f, 0.f, 0.f, 0.f};
        }
        for (int r = 0; r < 8; ++r) {
            const size_t row = (size_t)rb * 8 + r;
            f32x4 v[8]; float ss = 0.f;
#pragma unroll
            for (int j = 0; j < 8; ++j) {
                if (IN_BF16) { const u32x2 w = *(const u32x2*)((const bf16*)Xv + row * D + (64 * j + lane) * 4); v[j] = (f32x4){bf_lo(w.x), bf_hi(w.x), bf_lo(w.y), bf_hi(w.y)}; }
                else v[j] = *(const f32x4*)((const float*)Xv + row * D + (64 * j + lane) * 4);
                ss += (v[j][0] * v[j][0] + v[j][1] * v[j][1]) + (v[j][2] * v[j][2] + v[j][3] * v[j][3]); }
            if (xcopy) {
#pragma unroll
                for (int j = 0; j < 8; ++j) { u32x2 w; w.x = cvt_pk_bf16(v[j][0], v[j][1]); w.y = cvt_pk_bf16(v[j][2], v[j][3]); *(u32x2*)(xcopy + row * D + (64 * j + lane) * 4) = w; }
            }
            const float rstd = rsqrtf(wave_sum(ss) * (1.0f / D) + EPS);
#pragma unroll
            for (int j = 0; j < 8; ++j) {
                const f32x4 o = v[j] * rstd * A[j] + S[j];
                if (mod) { u32x2 w; w.x = cvt_pk_bf16(o[0], o[1]); w.y = cvt_pk_bf16(o[2], o[3]); *(u32x2*)(outb + row * D + (64 * j + lane) * 4) = w; }
                else *(f32x4*)(outf + row * D + (64 * j + lane) * 4) = o;
            }
        }
    }
}

__device__ __forceinline__ int att_off(int row, int ch) { const int a = (row >> 1) & 7, x = ((a & 1) << 2) | (a >> 1); return row * 128 + ((ch ^ x) << 4); }
__device__ __forceinline__ int crow(int r, int hi) { return (r & 3) + 8 * (r >> 2) + 4 * hi; }

struct AttUnit { int mode, type, head, dil, tok0, q0, qcol, kcol, vcol; };
__device__ __forceinline__ AttUnit att_decode_pair(int u) {
    AttUnit x; x.mode = 0; x.type = u >> 11; const int rem = u & 2047; x.head = rem & 15; const int qg = rem >> 4;
    x.dil = x.type <= 1 ? 1 : (x.type == 2 ? 4 : 16); const int nb = 16 / x.dil, seq = qg / nb, blk = qg % nb, b = seq / x.dil, rr = seq % x.dil;
    x.tok0 = b * SEQ + rr; x.q0 = blk * 128;
    x.qcol = 1280 + x.head * 64; x.kcol = 2304 + x.head * 64; x.vcol = 3328 + x.head * 64;
    return x;
}
__device__ __forceinline__ AttUnit att_decode_gqa(int g, int wave) {
    AttUnit x; x.mode = 1; x.type = 0; const int kvh = g & 1, qb = (g >> 1) & 63, b = g >> 7;
    x.head = 8 * kvh + wave; x.dil = 1; x.tok0 = b * SEQ; x.q0 = qb * 32;
    x.qcol = x.head * 64; x.kcol = 1024 + kvh * 64; x.vcol = 1152 + kvh * 64;
    return x;
}
__device__ __forceinline__ AttUnit att_decode_wide(int w) {
    AttUnit x; x.mode = 2; x.type = 1 + (w >> 10); const int rem = w & 1023; x.head = rem & 15; const int qg = rem >> 4;
    x.dil = x.type == 1 ? 1 : 4; const int nb = 8 / x.dil, seq = qg / nb, blk = qg % nb, b = seq / x.dil, rr = seq % x.dil;
    x.tok0 = b * SEQ + rr; x.q0 = blk * 256;
    x.qcol = 1280 + x.head * 64; x.kcol = 2304 + x.head * 64; x.vcol = 3328 + x.head * 64;
    return x;
}
__device__ __forceinline__ AttUnit att_unit_of(int it, int nG, int nW, int G, int half, int wave) {
    if (it < nG) return att_decode_gqa((int)blockIdx.x + it * G, wave);
    if (it < nG + nW) return att_decode_wide((int)blockIdx.x + (it - nG) * G);
    const int p = (int)blockIdx.x + (it - nG - nW) * G;
    return att_decode_pair(3 * 2048 + 2 * p + half);
}
__device__ __forceinline__ void att_issue(const bf16* P, const AttUnit& x, u32x4 (&kr)[8], u32x4 (&vr)[8], int tid, int htid) {
    const long vdelta = (long)(x.vcol - x.kcol) * 2;
    if (x.mode == 1) {
        const char* sb = (const char*)P + ((long)(x.tok0 + x.q0 - 128) * NIN + x.kcol) * 2;
        const unsigned voff = (unsigned)((tid >> 3) * NIN + (tid & 7) * 8) * 2u;
        const long istride = (long)64 * NIN * 2;
#pragma unroll
        for (int i = 0; i < 3; ++i) {
            if (i < 2 || tid < 256) { kr[i] = *(const u32x4*)(sb + i * istride + voff); vr[i] = *(const u32x4*)(sb + vdelta + i * istride + voff); }
            else { kr[i] = (u32x4){0u, 0u, 0u, 0u}; vr[i] = kr[i]; }
        }
#pragma unroll
        for (int i = 3; i < 8; ++i) { kr[i] = (u32x4){0u, 0u, 0u, 0u}; vr[i] = kr[i]; }
    } else if (x.mode == 2) {
        const char* sb = (const char*)P + ((long)(x.tok0 + (x.q0 - 128) * x.dil) * NIN + x.kcol) * 2;
        const unsigned voff = (unsigned)(((tid >> 3) * x.dil) * NIN + (tid & 7) * 8) * 2u;
        const long istride = (long)64 * x.dil * NIN * 2;
#pragma unroll
        for (int i = 0; i < 6; ++i) { kr[i] = *(const u32x4*)(sb + i * istride + voff); vr[i] = *(const u32x4*)(sb + vdelta + i * istride + voff); }
#pragma unroll
        for (int i = 6; i < 8; ++i) { kr[i] = (u32x4){0u, 0u, 0u, 0u}; vr[i] = kr[i]; }
    } else {
        const char* sb = (const char*)P + ((long)(x.tok0 + (x.q0 - 128) * x.dil) * NIN + x.kcol) * 2;
        const unsigned voff = (unsigned)(((htid >> 3) * x.dil) * NIN + (htid & 7) * 8) * 2u;
        const long istride = (long)32 * x.dil * NIN * 2;
        const bool skip4 = x.q0 == 0;
#pragma unroll
        for (int i = 0; i < 8; ++i) {
            if (i < 4 && skip4) { kr[i] = (u32x4){0u, 0u, 0u, 0u}; vr[i] = kr[i]; }
            else { kr[i] = *(const u32x4*)(sb + i * istride + voff); vr[i] = *(const u32x4*)(sb + vdelta + i * istride + voff); }
        }
    }
}
__device__ __forceinline__ void att_issue_q(const bf16* P, const AttUnit& x, bf16x8 (&qf)[4], int hw, int wave, int r32, int hi) {
    const int hwe = x.mode == 1 ? 0 : (x.mode == 2 ? wave : hw);
    const char* sq = (const char*)P + ((long)(x.tok0 + (x.q0 + 32 * hwe) * x.dil) * NIN + x.qcol) * 2;
    const unsigned qoff = (unsigned)((r32 * x.dil) * NIN + 8 * hi) * 2u;
#pragma unroll
    for (int s = 0; s < 4; ++s) qf[s] = *(const bf16x8*)(sq + 32 * s + qoff);
}

__device__ __forceinline__ void attn_phase(const Args& a, LAS unsigned char* lds, int tid, int lane, int wave, int G) {
    unsigned char* ws = a.ws;
    const bf16* P = (const bf16*)(ws + WS_PROJ);
    const int half = wave >> 2, hw = wave & 3, htid = tid & 255, r32 = lane & 31, hi = lane >> 5;
    LAS unsigned char* Kl = lds + half * 65536; LAS unsigned char* Vl = Kl + 32768;
    const float C2 = 0.125f * 1.4426950408889634f;
    const int blk16 = (lane >> 4) & 1, qq = (lane & 15) >> 2, pp = lane & 3;
    const int bx = (int)blockIdx.x;
    const int nG = bx < 1024 ? (1024 - 1 - bx) / G + 1 : 0, nW = bx < 2048 ? (2048 - 1 - bx) / G + 1 : 0, nP = bx < 1024 ? (1024 - 1 - bx) / G + 1 : 0, niter = nG + nW + nP;
    if (niter == 0) return;
    u32x4 kr[8], vr[8]; bf16x8 qn[4];
    AttUnit cur = att_unit_of(0, nG, nW, G, half, wave);
    att_issue(P, cur, kr, vr, tid, htid); att_issue_q(P, cur, qn, hw, wave, r32, hi);
    for (int it = 0; it < niter; ++it) {
        asm volatile("s_waitcnt lgkmcnt(0)\n\ts_barrier" ::: "memory");
        if (cur.mode == 1) {
#pragma unroll
            for (int i = 0; i < 3; ++i) { const int idx = i * 512 + tid, row = idx >> 3, ch = idx & 7; const int o = att_off(row, ch);
                if (i < 2 || tid < 256) { *(LAS u32x4*)(lds + o) = kr[i]; *(LAS u32x4*)(lds + 32768 + o) = vr[i]; } }
        } else if (cur.mode == 2) {
#pragma unroll
            for (int i = 0; i < 6; ++i) { const int idx = i * 512 + tid, row = idx >> 3, ch = idx & 7; const int o = att_off(row, ch); *(LAS u32x4*)(lds + o) = kr[i]; *(LAS u32x4*)(lds + 49152 + o) = vr[i]; }
        } else {
#pragma unroll
            for (int i = 0; i < 8; ++i) { const int idx = i * 256 + htid, row = idx >> 3, ch = idx & 7; const int o = att_off(row, ch); *(LAS u32x4*)(Kl + o) = kr[i]; *(LAS u32x4*)(Vl + o) = vr[i]; }
        }
        bf16x8 qf[4];
#pragma unroll
        for (int s = 0; s < 4; ++s) qf[s] = qn[s];
        asm volatile("s_waitcnt lgkmcnt(0)\n\ts_barrier" ::: "memory");
        const AttUnit x = cur;
        if (it + 1 < niter) { cur = att_unit_of(it + 1, nG, nW, G, half, wave); att_issue(P, cur, kr, vr, tid, htid); att_issue_q(P, cur, qn, hw, wave, r32, hi); }
        const int hwe = x.mode == 1 ? 0 : (x.mode == 2 ? wave : hw);
        LAS unsigned char* Kb = x.mode == 0 ? Kl : lds; LAS unsigned char* Vb = Kb + (x.mode == 2 ? 49152 : 32768);
        LAS unsigned char* kx[4]; LAS unsigned char* vx[2][2];
#pragma unroll
        for (int s = 0; s < 4; ++s) kx[s] = Kb + att_off(32 * hwe + r32, 2 * s + hi);
#pragma unroll
        for (int t = 0; t < 2; ++t)
#pragma unroll
            for (int c = 0; c < 2; ++c) vx[t][c] = Vb + att_off(32 * hwe + 4 * hi + qq + 8 * t, 4 * c + 2 * blk16 + (pp >> 1)) + 8 * (pp & 1);
        const int ql = 128 + 32 * hwe + r32;
        const int maxd = x.type == 0 ? 127 : 128;
        const float sink2 = x.type == 0 ? a.in[11][x.head] * 1.4426950408889634f : -INFINITY;
        float m = sink2, lsum = 0.f;
        f32x16 o[2]; o[0] = f32x16{}; o[1] = f32x16{};
#pragma unroll
        for (int ti = 4; ti >= 0; --ti) {
            const int tl = hwe + ti; const bool valid = (x.q0 - 128 + 32 * tl) >= 0;
            if (valid) {
                f32x16 acc = {};
#pragma unroll
                for (int s = 0; s < 4; ++s) { const bf16x8 kf = *(const LAS bf16x8*)(kx[s] + ti * 4096); acc = __builtin_amdgcn_mfma_f32_32x32x16_bf16(kf, qf[s], acc, 0, 0, 0); }
                float p[16]; float tmax = -INFINITY;
                if (ti == 4 || ti == 0) {
#pragma unroll
                    for (int r = 0; r < 16; ++r) { const int dd = ql - (32 * tl + crow(r, hi)); const bool ok = dd >= 0 && dd <= maxd; p[r] = ok ? acc[r] * C2 : -INFINITY; tmax = fmaxf(tmax, p[r]); }
                } else {
#pragma unroll
                    for (int r = 0; r < 16; ++r) { p[r] = acc[r] * C2; tmax = fmaxf(tmax, p[r]); }
                }
                tmax = fmaxf(tmax, __shfl_xor(tmax, 32));
                const float mnew = fmaxf(m, tmax);
                if (__any(mnew > m)) {
                    const float alpha = __builtin_amdgcn_exp2f(m - mnew);
                    lsum *= alpha;
#pragma unroll
                    for (int r = 0; r < 16; ++r) { o[0][r] *= alpha; o[1][r] *= alpha; }
                }
                m = mnew;
#pragma unroll
                for (int r = 0; r < 16; ++r) { p[r] = __builtin_amdgcn_exp2f(p[r] - mnew); lsum += p[r]; }
#pragma unroll
                for (int sp = 0; sp < 2; ++sp) {
                    u32x4 pw; pw.x = cvt_pk_bf16(p[8 * sp + 0], p[8 * sp + 1]); pw.y = cvt_pk_bf16(p[8 * sp + 2], p[8 * sp + 3]); pw.z = cvt_pk_bf16(p[8 * sp + 4], p[8 * sp + 5]); pw.w = cvt_pk_bf16(p[8 * sp + 6], p[8 * sp + 7]);
                    const bf16x8 pb = __builtin_bit_cast(bf16x8, pw);
#pragma unroll
                    for (int c = 0; c < 2; ++c) {
                        const s16x4 v0 = __builtin_bit_cast(s16x4, __builtin_amdgcn_ds_read_tr16_b64_v4i16((LAS s16x4*)(vx[0][c] + ti * 4096 + sp * 2048)));
                        const s16x4 v1 = __builtin_bit_cast(s16x4, __builtin_amdgcn_ds_read_tr16_b64_v4i16((LAS s16x4*)(vx[1][c] + ti * 4096 + sp * 2048)));
                        const bf16x8 vf = (bf16x8){v0[0], v0[1], v0[2], v0[3], v1[0], v1[1], v1[2], v1[3]};
                        o[c] = __builtin_amdgcn_mfma_f32_32x32x16_bf16(vf, pb, o[c], 0, 0, 0);
                    }
                }
            }
        }
        lsum += __shfl_xor(lsum, 32);
        if (x.type == 0) lsum += __builtin_amdgcn_exp2f(sink2 - m);
        const float inv = 1.0f / lsum;
        const size_t qtok = (size_t)(x.tok0 + (x.q0 + 32 * hwe + r32) * x.dil);
        bf16* outp = x.type == 0 ? (bf16*)(ws + WS_OA) : (bf16*)(ws + WS_OB) + (size_t)(x.type - 1) * T * 1024;
        bf16* op = outp + qtok * 1024 + x.head * 64 + 4 * hi;
#pragma unroll
        for (int c = 0; c < 2; ++c)
#pragma unroll
            for (int gq = 0; gq < 4; ++gq) { u32x2 w; w.x = cvt_pk_bf16(o[c][4 * gq] * inv, o[c][4 * gq + 1] * inv); w.y = cvt_pk_bf16(o[c][4 * gq + 2] * inv, o[c][4 * gq + 3] * inv); *(u32x2*)(op + 32 * c + 8 * gq) = w; }
        if (x.type != 0 && hi == 0) { float* lsep = (float*)(ws + WS_LSE) + (size_t)(x.type - 1) * T * 16; lsep[qtok * 16 + x.head] = (m + __log2f(lsum)) * 0.6931471805599453f; }
    }
}

__device__ __forceinline__ void combine_phase(const Args& a, int gw, int NGW, int lane) {
    unsigned char* ws = a.ws;
    const bf16* OA = (const bf16*)(ws + WS_OA); const bf16* OB = (const bf16*)(ws + WS_OB); const float* LSE = (const float*)(ws + WS_LSE); bf16* Y = (bf16*)(ws + WS_A);
    const float* ga = a.in[12] + 16 * lane; const float* gb = a.in[13] + 16 * lane;
    float GA[16], GB[16];
#pragma unroll
    for (int i = 0; i < 4; ++i) { const f32x4 x = *(const f32x4*)(ga + 4 * i), y = *(const f32x4*)(gb + 4 * i);
#pragma unroll
        for (int j = 0; j < 4; ++j) { GA[4 * i + j] = x[j]; GB[4 * i + j] = y[j]; } }
    for (int tok = gw; tok < T; tok += NGW) {
        float v[16];
        {
            const u32x4 w0 = *(const u32x4*)(OA + (size_t)tok * 1024 + 16 * lane), w1 = *(const u32x4*)(OA + (size_t)tok * 1024 + 16 * lane + 8);
#pragma unroll
            for (int i = 0; i < 4; ++i) { v[2 * i] = bf_lo(w0[i]); v[2 * i + 1] = bf_hi(w0[i]); v[8 + 2 * i] = bf_lo(w1[i]); v[8 + 2 * i + 1] = bf_hi(w1[i]); }
            float ss = 0.f;
#pragma unroll
            for (int i = 0; i < 16; ++i) ss += v[i] * v[i];
            const float rstd = rsqrtf(wave_sum(ss) * (1.0f / 1024.0f) + EPS);
            u32x4 o0, o1;
#pragma unroll
            for (int i = 0; i < 4; ++i) { o0[i] = cvt_pk_bf16(v[2 * i] * rstd * GA[2 * i], v[2 * i + 1] * rstd * GA[2 * i + 1]); o1[i] = cvt_pk_bf16(v[8 + 2 * i] * rstd * GA[8 + 2 * i], v[9 + 2 * i] * rstd * GA[9 + 2 * i]); }
            *(u32x4*)(Y + (size_t)tok * D + 16 * lane) = o0; *(u32x4*)(Y + (size_t)tok * D + 16 * lane + 8) = o1;
        }
        {
            const int h = lane >> 2;
            const float l0 = LSE[(size_t)tok * 16 + h], l1 = LSE[(size_t)T * 16 + (size_t)tok * 16 + h], l2 = LSE[(size_t)2 * T * 16 + (size_t)tok * 16 + h];
            const float m = fmaxf(l0, fmaxf(l1, l2)); float e0 = __expf(l0 - m), e1 = __expf(l1 - m), e2 = __expf(l2 - m); const float is = 1.0f / (e0 + e1 + e2);
            const float wgt[3] = {e0 * is, e1 * is, e2 * is};
#pragma unroll
            for (int i = 0; i < 16; ++i) v[i] = 0.f;
#pragma unroll
            for (int c = 0; c < 3; ++c) {
                const bf16* src = OB + (size_t)c * T * 1024 + (size_t)tok * 1024 + 16 * lane;
                const u32x4 w0 = *(const u32x4*)(src), w1 = *(const u32x4*)(src + 8);
#pragma unroll
                for (int i = 0; i < 4; ++i) { v[2 * i] += wgt[c] * bf_lo(w0[i]); v[2 * i + 1] += wgt[c] * bf_hi(w0[i]); v[8 + 2 * i] += wgt[c] * bf_lo(w1[i]); v[9 + 2 * i] += wgt[c] * bf_hi(w1[i]); }
            }
            float ss = 0.f;
#pragma unroll
            for (int i = 0; i < 16; ++i) ss += v[i] * v[i];
            const float rstd = rsqrtf(wave_sum(ss) * (1.0f / 1024.0f) + EPS);
            u32x4 o0, o1;
#pragma unroll
            for (int i = 0; i < 4; ++i) { o0[i] = cvt_pk_bf16(v[2 * i] * rstd * GB[2 * i], v[2 * i + 1] * rstd * GB[2 * i + 1]); o1[i] = cvt_pk_bf16(v[8 + 2 * i] * rstd * GB[8 + 2 * i], v[9 + 2 * i] * rstd * GB[9 + 2 * i]); }
            *(u32x4*)(Y + (size_t)tok * D + 1024 + 16 * lane) = o0; *(u32x4*)(Y + (size_t)tok * D + 1024 + 16 * lane + 8) = o1;
        }
    }
}

#define XB_TMO      128
#define XB_XCNT(j)  (256  + 64 * (j))
#define XB_XSUB(j)  (1280 + 64 * (j))
#define XB_XGEN(j)  (2304 + 64 * (j))
#define XB_TOP      3328
#define XB_TOPGEN   3392
#define XCD_BAR_WORDS 3456
#define XB_SPIN_CAP (1u << 24)

__device__ __forceinline__ unsigned xb_ld(unsigned* p)              { return __hip_atomic_load(p, __ATOMIC_RELAXED, __HIP_MEMORY_SCOPE_AGENT); }
__device__ __forceinline__ unsigned xb_add(unsigned* p, unsigned v) { return __hip_atomic_fetch_add(p, v, __ATOMIC_RELAXED, __HIP_MEMORY_SCOPE_AGENT); }
__device__ __forceinline__ unsigned xb_xcc_id() { return (unsigned)__builtin_amdgcn_s_getreg((3 << 11) | 20) & 0xFu; }
#define XB_SPIN(cond, bar) do { unsigned _sp = 0; while (cond) { __builtin_amdgcn_s_sleep(1); \
    if ((++_sp & 255u) == 0u) { if (xb_ld(&(bar)[XB_TMO])) break; if (_sp > XB_SPIN_CAP) { atomicAdd(&(bar)[XB_TMO], 1u); break; } } } } while (0)

struct XcdBarrier {
    unsigned* bar; unsigned x;
    volatile LAS unsigned* st;
};

__device__ __forceinline__ XcdBarrier xcd_barrier_post(unsigned* bar, volatile LAS unsigned* st) {
    XcdBarrier b; b.bar = bar; b.x = xb_xcc_id(); b.st = st;
    if (threadIdx.x == 0) (void)xb_add(&bar[XB_XCNT(b.x)], 1u);
    return b;
}
__device__ __forceinline__ void xcd_barrier_complete(unsigned* bar, unsigned x, unsigned& nloc, unsigned& nx) {
    const unsigned G = gridDim.x * gridDim.y * gridDim.z;
    unsigned sum, cnt, mine, sp = 0u;
    for (;;) {
        sum = 0u; cnt = 0u; mine = 0u;
#pragma unroll
        for (unsigned j = 0; j < 16; ++j) { const unsigned c = xb_ld(&bar[XB_XCNT(j)]); sum += c; cnt += (c > 0u) ? 1u : 0u; mine = (j == x) ? c : mine; }
        if (sum == G) break;
        __builtin_amdgcn_s_sleep(1);
        if ((++sp & 255u) == 0u) { if (xb_ld(&bar[XB_TMO])) break; if (sp > XB_SPIN_CAP) { atomicAdd(&bar[XB_TMO], 1u); break; } }
    }
    nloc = mine > 0u ? mine : 1u; nx = cnt > 0u ? cnt : 1u;
}

__device__ __forceinline__ void xcd_barrier(const XcdBarrier& b) {
    asm volatile("s_waitcnt vmcnt(0)" ::: "memory");
    __syncthreads();
    if (threadIdx.x == 0) {
        unsigned* bar = b.bar;
        __builtin_amdgcn_s_waitcnt(0);
        unsigned nloc = b.st[0], nx = b.st[1];
        if (nloc == 0u) { xcd_barrier_complete(bar, b.x, nloc, nx); b.st[0] = nloc; b.st[1] = nx; }
        const unsigned old = xb_add(&bar[XB_XSUB(b.x)], 1u);
        const unsigned gen = old / nloc;
        if (old + 1u == (gen + 1u) * nloc) {
            __builtin_amdgcn_fence(__ATOMIC_RELEASE, "agent");
            asm volatile("s_waitcnt vmcnt(0)" ::: "memory");
            const unsigned og = xb_add(&bar[XB_TOP], 1u);
            const unsigned tg = og / nx;
            if (og + 1u == (tg + 1u) * nx) xb_add(&bar[XB_TOPGEN], 1u);
            else XB_SPIN(xb_ld(&bar[XB_TOPGEN]) == tg, bar);
            __builtin_amdgcn_fence(__ATOMIC_ACQUIRE, "agent");
            xb_add(&bar[XB_XGEN(b.x)], 1u);
            asm volatile("s_waitcnt vmcnt(0)" ::: "memory");
        } else {
            XB_SPIN(xb_ld(&bar[XB_XGEN(b.x)]) == gen, bar);
            __builtin_amdgcn_fence(__ATOMIC_ACQUIRE, "agent");
            asm volatile("s_waitcnt vmcnt(0)" ::: "memory");
        }
    }
    __syncthreads();
}


__global__ void __launch_bounds__(512, 2) mk_fwd(Args a) {
    extern __shared__ __attribute__((aligned(16))) unsigned char lds_raw[];
    LAS unsigned char* lds = (LAS unsigned char*)lds_raw;
    const int tid = threadIdx.x, lane = tid & 63, wave = __builtin_amdgcn_readfirstlane(tid >> 6);
    const int G = gridDim.x, gw = blockIdx.x * 8 + wave, NGW = G * 8;
    unsigned char* ws = a.ws;
    bf16* Abuf = (bf16*)(ws + WS_A); bf16* U = (bf16*)(ws + WS_U); bf16* XB = (bf16*)(ws + WS_XB); const float* mod = (const float*)(ws + WS_MOD);
#ifndef PHM
#define PHM 0xffff
#endif
#define HAS(k) ((PHM >> (k)) & 1)
    const int lo = a.ph_lo, hi = a.ph_hi;
    volatile LAS unsigned* MISC = (volatile LAS unsigned*)(lds + LDS_BYTES - 256);
    if (tid < 64) MISC[tid] = 0u;
    __syncthreads();
    XcdBarrier xbar; xbar.bar = (unsigned*)(ws + WS_CTL + 16384); xbar.x = 0; xbar.st = nullptr;
    if (hi - lo > 1) xbar = xcd_barrier_post((unsigned*)(ws + WS_CTL + 16384), MISC + 8);
#ifndef REPM
#define REPM 0
#endif
#define REP(k) (((REPM >> (k)) & 1) ? 2 : 1)
#define IN(k) (HAS(k) && lo <= (k) && (k) < hi)
#define SEAM(k) do { if ((k) + 1 < hi && lo <= (k)) { xcd_barrier(xbar); } } while (0)
#define NORM_PH(k, BF, Xp, gp, sub) if (IN(k)) for (int rep_ = 0; rep_ < REP(k); ++rep_) { norm_phase<BF>(Xp, gp, mod, sub, Abuf, nullptr, gw, NGW, lane); } SEAM(k)
#define SWIGLU_PH(k, WOFF) if (IN(k)) for (int rep_ = 0; rep_ < REP(k); ++rep_) { pg8::Gemm g{Abuf, (const bf16*)(ws + (WOFF)), T, 2 * FF, D}; pg8::StaticOrder S; S.init(T, 2 * FF, G, (int)blockIdx.x); \
        pg8::EpiSwiglu E{U, FF}; pg8::gemm_phase<pg8::EpiSwiglu, pg8::StaticOrder, GEMM_ALIGN, GEMM_SP2>(lds, g, S, E); } SEAM(k)
#define RESID_PH(k, BF, Ap, WOFF, KK, basep, biasp, sub, gs) if (IN(k)) for (int rep_ = 0; rep_ < REP(k); ++rep_) { pg8::Gemm g{Ap, (const bf16*)(ws + (WOFF)), T, D, KK}; pg8::StaticOrder S; S.init(T, D, G, (int)blockIdx.x); \
        pg8::EpiResid<BF> E{basep, XB, biasp, mod + ((sub) * 3 + 2) * D, gs, D, NMOD}; pg8::gemm_phase<pg8::EpiResid<BF>, pg8::StaticOrder, GEMM_ALIGN, GEMM_SP2>(lds, g, S, E); } SEAM(k)
    if (hi > 1000) cg::this_grid().sync();
    if (IN(0)) for (int rep_ = 0; rep_ < REP(0); ++rep_) { p0_prep(a, lds, tid, lane, wave, G, rep_); __syncthreads(); }
    SEAM(0);
    if (IN(1)) norm_phase<false>(a.in[0], a.in[5], mod, 0, Abuf, nullptr, gw, NGW, lane, XB);
    SEAM(1);
    SWIGLU_PH(2, WS_WGU1);
    RESID_PH(3, true, U, WS_WD1, FF, XB, nullptr, 0, 0.5f);
    NORM_PH(4, true, XB, a.in[8], 1);
    if (IN(5)) for (int rep_ = 0; rep_ < REP(5); ++rep_) {
        pg8::Gemm g{Abuf, (const bf16*)(ws + WS_WIN), T, NIN, D}; pg8::StaticOrder S; S.init(T, NIN, G, (int)blockIdx.x);
        pg8::EpiQKV E{(bf16*)(ws + WS_PROJ), a.in[10], (const float*)(ws + WS_ROPE), NIN};
        pg8::gemm_phase<pg8::EpiQKV, pg8::StaticOrder, GEMM_ALIGN, GEMM_SP2>(lds, g, S, E);
        __syncthreads();
        transpose_queue(a, lds, lane, wave, 1);
    }
    SEAM(5);
    if (IN(6)) for (int rep_ = 0; rep_ < REP(6); ++rep_) attn_phase(a, lds, tid, lane, wave, G);
    SEAM(6);
    if (IN(7)) for (int rep_ = 0; rep_ < REP(7); ++rep_) combine_phase(a, gw, NGW, lane);
    SEAM(7);
    RESID_PH(8, true, Abuf, WS_WOUT, D, XB, a.in[15], 1, 1.0f);
    NORM_PH(9, true, XB, a.in[16], 2);
    SWIGLU_PH(10, WS_WGU2);
    RESID_PH(11, true, U, WS_WD2, FF, XB, nullptr, 2, 0.5f);
    if (IN(12)) norm_phase<true>(XB, a.in[19], nullptr, 0, nullptr, a.out, gw, NGW, lane);
}

extern "C" void kernel_launch(void* const* d_in, const int* in_sizes, int n_in, void* d_out, int out_size, void* d_ws, size_t ws_size, hipStream_t stream) {
    static int grid = 0;
    if (grid == 0) {
        if (n_in != 20 || in_sizes[0] != T * D || out_size != T * D || ws_size < WS_END) { fprintf(stderr, "kernel_launch: unexpected shapes / workspace (n_in %d, in0 %d, out %d, ws %zu < %zu)\n", n_in, n_in > 0 ? in_sizes[0] : -1, out_size, ws_size, (size_t)WS_END); grid = -1; return; }
        int dev = 0, cus = 0, per_cu = 0;
        if (hipGetDevice(&dev) != hipSuccess || hipDeviceGetAttribute(&cus, hipDeviceAttributeMultiprocessorCount, dev) != hipSuccess) { grid = -1; return; }
        if (hipFuncSetAttribute((const void*)mk_fwd, hipFuncAttributeMaxDynamicSharedMemorySize, LDS_BYTES) != hipSuccess) { fprintf(stderr, "kernel_launch: hipFuncSetAttribute failed\n"); grid = -1; return; }
        if (hipOccupancyMaxActiveBlocksPerMultiprocessor(&per_cu, (const void*)mk_fwd, 512, LDS_BYTES) != hipSuccess || per_cu < 1) { fprintf(stderr, "kernel_launch: occupancy query says %d\n", per_cu); per_cu = 1; }
        (void)hipGetLastError();
        grid = cus * per_cu;
    }
    if (grid < 0) return;
    (void)hipMemsetAsync((char*)d_ws + WS_CTL, 0, 65536, stream);
    Args a{};
    for (int i = 0; i < 20; ++i) a.in[i] = (const float*)d_in[i];
    a.out = (float*)d_out; a.ws = (unsigned char*)d_ws;
    for (int i = 0; i < 8; ++i) a.invf[i] = powf(500000.0f, -((float)(2 * i) / 16.0f));
#if MK_MULTI
#ifndef DBG_LAST
#define DBG_LAST (NPH - 1)
#endif
    for (int ph = 0; ph <= DBG_LAST; ++ph) {
#ifdef DBG_SKIP
        if ((DBG_SKIP >> ph) & 1) continue;
#endif
        a.ph_lo = ph; a.ph_hi = ph + 1; hipLaunchKernelGGL(mk_fwd, dim3(grid), dim3(512), LDS_BYTES, stream, a); }
#else
    a.ph_lo = 0; a.ph_hi = NPH;
    void* args[] = {&a};
    hipError_t e = hipLaunchCooperativeKernel((const void*)mk_fwd, dim3(grid), dim3(512), args, LDS_BYTES, stream);
    if (e != hipSuccess) fprintf(stderr, "cooperative launch failed: %s (grid %d)\n", hipGetErrorString(e), grid);
#endif
}
```

```cpp
#include <hip/hip_runtime.h>
#include <hip/hip_cooperative_groups.h>
#include <cstdio>
#include <cstdint>
#include <cmath>
namespace cg = cooperative_groups;
#ifndef MK_MULTI
#define MK_MULTI 0
#ifndef GEMM_ALIGN
#define GEMM_ALIGN true
#endif
#ifndef GEMM_SP2
#define GEMM_SP2 true
#endif
#endif
namespace pg8 {
#define PG8_LAS __attribute__((address_space(3)))
typedef unsigned short bf16_t;
typedef short bf16x8 __attribute__((ext_vector_type(8)));
typedef float f32x4 __attribute__((ext_vector_type(4)));
typedef unsigned u32x4 __attribute__((ext_vector_type(4)));
constexpr int BM = 256, BK = 64, HALF = 128, HTB = HALF * BK * 2  , STAGE_BYTES = 8 * HTB, NXCD = 8, WGM = 8;

__host__ __device__ __forceinline__ int lds_byte(int r, int c) { const int st = (r >> 4) * 2 + (c >> 5), rr = r & 15, cc = c & 31, ob = rr * 64 + cc * 2; return st * 1024 + (ob ^ (((ob >> 9) & 1) << 5)); }
__host__ __device__ __forceinline__ void stage_rc(int b, int& R, int& C) { const int st = b / 1024, sb = b % 1024, swz = sb ^ (((sb >> 9) & 1) << 5); R = (st >> 1) * 16 + swz / 64; C = (st & 1) * 32 + (swz % 64) / 2; }
__host__ __device__ __forceinline__ int perm32(int rho) { const int n = rho >> 4, i = rho & 15; return 8 * (i >> 2) + 4 * n + (i & 3); }

struct Unit { int pm, pn; };
struct Gemm { const bf16_t* A; const bf16_t* Bt; int M, N, K; };

struct StaticOrder {
    int nM, nN, nwg, G, c;
    __host__ __device__ void init(int M, int N, int G_, int c_) { nM = M / BM; nN = N / BM; nwg = nM * nN; G = G_; c = c_; }
    __host__ __device__ bool next(int i, Unit& u) const {
        const long L = (long)i * G + c; if (L >= nwg) return false;
        int wgid = (int)L; { const int q = nwg / NXCD, r = nwg % NXCD, xcd = wgid % NXCD, off = wgid / NXCD; wgid = (xcd < r ? xcd * (q + 1) : r * (q + 1) + (xcd - r) * q) + off; }
        const int nig = WGM * nN, gid = wgid / nig, fm = gid * WGM, gsz = (nM - fm) < WGM ? (nM - fm) : WGM;
        u.pm = fm + ((wgid % nig) % gsz); u.pn = (wgid % nig) / gsz; return true;
    }
    __device__ __forceinline__ void a_ready(const Unit&) const {}
    __device__ __forceinline__ void done(const Unit&) const {}
};

typedef float f32x2_t __attribute__((ext_vector_type(2))); typedef __bf16 bf16x2_t __attribute__((ext_vector_type(2)));
__device__ __forceinline__ unsigned cvt_pk_bf16(float lo, float hi) { f32x2_t v = {lo, hi}; bf16x2_t b = __builtin_convertvector(v, bf16x2_t); return __builtin_bit_cast(unsigned, b); }
__device__ __forceinline__ float silu_mul(float g, float u) { return g * u * __builtin_amdgcn_rcpf(1.0f + __builtin_amdgcn_exp2f(-1.4426950408889634f * g)); }

struct EpiSwiglu {
    static constexpr bool PERM = true, AFTER_DRAIN = false;
    bf16_t* O; int ldo;
    __device__ __forceinline__ void operator()(const f32x4 (&acc)[2][2][4][2], const Unit& u, int wr, int wc, int fr, int fq) const {
        const int row0 = u.pm * BM + wr * 64 + fr, col0 = u.pn * HALF + wc * 32 + 8 * fq;
#ifdef PROBE_SWEPI2
      for (int rp_ = 0; rp_ < 2; ++rp_) { asm volatile("" ::: "memory");
#endif
#pragma unroll
        for (int ai = 0; ai < 2; ++ai)
#pragma unroll
            for (int m = 0; m < 4; ++m) {
                bf16_t* p = O + (size_t)(row0 + ai * HALF + m * 16) * ldo + col0;
                const f32x4 g0 = acc[ai][0][m][0], g1 = acc[ai][0][m][1], u0 = acc[ai][1][m][0], u1 = acc[ai][1][m][1];
                u32x4 w;
                w.x = cvt_pk_bf16(silu_mul(g0[0], u0[0]), silu_mul(g0[1], u0[1]));
                w.y = cvt_pk_bf16(silu_mul(g0[2], u0[2]), silu_mul(g0[3], u0[3]));
                w.z = cvt_pk_bf16(silu_mul(g1[0], u1[0]), silu_mul(g1[1], u1[1]));
                w.w = cvt_pk_bf16(silu_mul(g1[2], u1[2]), silu_mul(g1[3], u1[3]));
                *(u32x4*)p = w;
            }
#ifdef PROBE_SWEPI2
      }
#endif
    }
};

template <bool BASE_BF16> struct EpiResid {
    static constexpr bool PERM = true, AFTER_DRAIN = false;
    const void* base; bf16_t* out; const float* bias; const float* gatev; float gs; int ldc, gstride;
    __device__ __forceinline__ void operator()(const f32x4 (&acc)[2][2][4][2], const Unit& u, int wr, int wc, int fr, int fq) const {
        const float* gp = gatev + (size_t)(u.pm >> 3) * gstride;
        const int row0 = u.pm * BM + wr * 64 + fr, colb = u.pn * BM + wc * 32 + 8 * fq;
        u32x4 bw[2][2][4];
        if (BASE_BF16) {
#pragma unroll
            for (int bj = 0; bj < 2; ++bj)
#pragma unroll
                for (int ai = 0; ai < 2; ++ai)
#pragma unroll
                    for (int m = 0; m < 4; ++m) bw[bj][ai][m] = *(const u32x4*)((const bf16_t*)base + (size_t)(row0 + ai * HALF + m * 16) * ldc + colb + bj * HALF);
        }
#pragma unroll
        for (int bj = 0; bj < 2; ++bj) {
            const int col0 = colb + bj * HALF;
            const f32x4 g0 = *(const f32x4*)(gp + col0) * gs, g1 = *(const f32x4*)(gp + col0 + 4) * gs;
            const f32x4 b0 = bias ? *(const f32x4*)(bias + col0) : (f32x4){0.f, 0.f, 0.f, 0.f}, b1 = bias ? *(const f32x4*)(bias + col0 + 4) : (f32x4){0.f, 0.f, 0.f, 0.f};
#pragma unroll
            for (int ai = 0; ai < 2; ++ai)
#pragma unroll
                for (int m = 0; m < 4; ++m) {
                    const size_t off = (size_t)(row0 + ai * HALF + m * 16) * ldc + col0;
                    f32x4 s0, s1;
                    if (BASE_BF16) { const u32x4 w = bw[bj][ai][m];
                        s0 = (f32x4){__uint_as_float(w.x << 16), __uint_as_float(w.x & 0xffff0000u), __uint_as_float(w.y << 16), __uint_as_float(w.y & 0xffff0000u)};
                        s1 = (f32x4){__uint_as_float(w.z << 16), __uint_as_float(w.z & 0xffff0000u), __uint_as_float(w.w << 16), __uint_as_float(w.w & 0xffff0000u)}; }
                    else { s0 = *(const f32x4*)((const float*)base + off); s1 = *(const f32x4*)((const float*)base + off + 4); }
                    const f32x4 v0 = s0 + g0 * (acc[ai][bj][m][0] + b0), v1 = s1 + g1 * (acc[ai][bj][m][1] + b1);
                    u32x4 w; w.x = cvt_pk_bf16(v0[0], v0[1]); w.y = cvt_pk_bf16(v0[2], v0[3]); w.z = cvt_pk_bf16(v1[0], v1[1]); w.w = cvt_pk_bf16(v1[2], v1[3]);
                    *(u32x4*)(out + off) = w;
                }
        }
    }
};

struct EpiQKV {
    static constexpr bool PERM = true, AFTER_DRAIN = false;
    bf16_t* O; const float* bias; const float* rope; int ldo;
    __device__ __forceinline__ void operator()(const f32x4 (&acc)[2][2][4][2], const Unit& u, int wr, int wc, int fr, int fq) const {
        const int row0 = u.pm * BM + wr * 64 + fr;
#pragma unroll
        for (int bj = 0; bj < 2; ++bj) {
            const int ch = u.pn * BM + bj * HALF;
            const bool rope_on = ((ch < 1152) || (ch >= 1280 && ch < 3328)) && ((wc & 1) == 0);
            const int col0 = ch + wc * 32 + 8 * fq;
            const f32x4 b0 = *(const f32x4*)(bias + col0), b1 = *(const f32x4*)(bias + col0 + 4);
#pragma unroll
            for (int ai = 0; ai < 2; ++ai)
#pragma unroll
                for (int m = 0; m < 4; ++m) {
                    const int row = row0 + ai * HALF + m * 16;
                    f32x4 x0 = acc[ai][bj][m][0] + b0, x1 = acc[ai][bj][m][1] + b1;
                    if (rope_on) {
                        f32x4 y0, y1;
#pragma unroll
                        for (int i = 0; i < 4; ++i) { y0[i] = __shfl_xor(x0[i], 16); y1[i] = __shfl_xor(x1[i], 16); }
                        if (fq < 2) {
                            const float* rp = rope + (size_t)row * 16;
                            const f32x4 c0 = *(const f32x4*)(rp), c1 = *(const f32x4*)(rp + 4), s0 = *(const f32x4*)(rp + 8), s1 = *(const f32x4*)(rp + 12);
                            if (fq == 0) { x0 = x0 * c0 - y0 * s0; x1 = x1 * c1 - y1 * s1; }
                            else         { x0 = x0 * c0 + y0 * s0; x1 = x1 * c1 + y1 * s1; }
                        }
                    }
                    u32x4 w; w.x = cvt_pk_bf16(x0[0], x0[1]); w.y = cvt_pk_bf16(x0[2], x0[3]); w.z = cvt_pk_bf16(x1[0], x1[1]); w.w = cvt_pk_bf16(x1[2], x1[3]);
                    *(u32x4*)(O + (size_t)row * ldo + col0) = w;
                }
        }
    }
};

template <class Epi, class Sched, bool ALIGN_EPI = false, bool SP2 = false>
__device__ __forceinline__ void gemm_phase(PG8_LAS unsigned char* lds, const Gemm g, const Sched& S, const Epi& E) {
    const int tid = threadIdx.x, wid = __builtin_amdgcn_readfirstlane(tid >> 6), lane = tid & 63, wr = wid >> 2, wc = wid & 3, fr = lane & 15, fq = lane >> 4;
    const int K = g.K, nt = K / BK;
    unsigned voffA[2], voffB[2];
#pragma unroll
    for (int i = 0; i < 2; ++i) { int R, C; stage_rc(tid * 16 + i * 8192, R, C); const int Rb = Epi::PERM ? ((R & ~31) + perm32(R & 31)) : R;
        voffA[i] = (unsigned)(R * K + C) * 2u; voffB[i] = (unsigned)(Rb * K + C) * 2u; }
    const size_t kstep = (size_t)(BK * 2);
    const size_t hstep = (size_t)HALF * K * 2;
    const size_t tstep = 2 * hstep;
    const unsigned ldsw = (unsigned)wid * 1024u;
    const int aoff = lds_byte(wr * 64 + fr, fq * 8), boff = lds_byte(wc * 32 + fr, fq * 8);
#define PG8_SA(b, h) (((b) * 2 + (h)) * HTB)
#define PG8_SB(b, h) ((4 + (b) * 2 + (h)) * HTB)
#define PG8_STAGE(bufoff, gbase, voff) do { _Pragma("unroll") for (int _i = 0; _i < 2; ++_i) \
        __builtin_amdgcn_global_load_lds((const unsigned*)((const char*)(gbase) + (voff)[_i]), (PG8_LAS unsigned*)(lds + (bufoff) + ldsw + _i * 8192), 16, 0, 0); } while (0)
#define PG8_LDA(dst, b, h) do { _Pragma("unroll") for (int m = 0; m < 4; ++m) _Pragma("unroll") for (int k = 0; k < 2; ++k) dst[m][k] = *(const PG8_LAS bf16x8*)(lds + PG8_SA(b, h) + aoff + m * 2048 + k * 1024); } while (0)
#define PG8_LDB(dst, b, h) do { _Pragma("unroll") for (int n = 0; n < 2; ++n) _Pragma("unroll") for (int k = 0; k < 2; ++k) dst[n][k] = *(const PG8_LAS bf16x8*)(lds + PG8_SB(b, h) + boff + n * 2048 + k * 1024); } while (0)
#define PG8_MMA(ai, bj, At, Bt) do { __builtin_amdgcn_s_setprio(1); _Pragma("unroll") for (int m = 0; m < 4; ++m) _Pragma("unroll") for (int n = 0; n < 2; ++n) _Pragma("unroll") for (int k = 0; k < 2; ++k) \
        acc[ai][bj][m][n] = __builtin_amdgcn_mfma_f32_16x16x32_bf16(Bt[n][k], At[m][k], acc[ai][bj][m][n], 0, 0, 0); __builtin_amdgcn_s_setprio(0); } while (0)
#define PG8_WAIT_V(n) asm volatile("s_waitcnt vmcnt(" #n ")" ::: "memory")
#define PG8_WAIT_L(n) asm volatile("s_waitcnt lgkmcnt(" #n ")" ::: "memory")
#define PG8_BAR __builtin_amdgcn_s_barrier()
#define PG8_SCHED __builtin_amdgcn_sched_barrier(0)
    Unit cur, nxt; int ui = 0;
    if (!S.next(0, cur)) return;
    f32x4 acc[2][2][4][2];
#pragma unroll
    for (int a = 0; a < 2; ++a)
#pragma unroll
        for (int b = 0; b < 2; ++b)
#pragma unroll
            for (int m = 0; m < 4; ++m)
#pragma unroll
                for (int n = 0; n < 2; ++n) acc[a][b][m][n] = (f32x4){0.f, 0.f, 0.f, 0.f};
    bf16x8 At[4][2], B0[2][2], B1[2][2];
    const char* cA = (const char*)g.A + (size_t)cur.pm * tstep; const char* cB = (const char*)g.Bt + (size_t)cur.pn * tstep;
    S.a_ready(cur);
    if constexpr (SP2) {
        PG8_STAGE(PG8_SB(0, 0), cB, voffB); PG8_STAGE(PG8_SB(0, 1), cB + hstep, voffB); PG8_STAGE(PG8_SA(0, 0), cA, voffA); PG8_STAGE(PG8_SA(0, 1), cA + hstep, voffA);
        if (wr == 1) PG8_BAR;
        PG8_WAIT_V(2); PG8_BAR;
        PG8_STAGE(PG8_SB(1, 0), cB + kstep, voffB); PG8_STAGE(PG8_SA(1, 0), cA + kstep, voffA); PG8_STAGE(PG8_SB(1, 1), cB + hstep + kstep, voffB);
        PG8_WAIT_V(6); PG8_BAR;
    } else {
        PG8_STAGE(PG8_SB(0, 0), cB, voffB); PG8_STAGE(PG8_SA(0, 0), cA, voffA); PG8_STAGE(PG8_SB(0, 1), cB + hstep, voffB); PG8_STAGE(PG8_SA(0, 1), cA + hstep, voffA);
        if (wr == 1) PG8_BAR;
        PG8_WAIT_V(4); PG8_BAR;
        PG8_STAGE(PG8_SB(1, 0), cB + kstep, voffB); PG8_STAGE(PG8_SA(1, 0), cA + kstep, voffA); PG8_STAGE(PG8_SB(1, 1), cB + hstep + kstep, voffB);
        PG8_WAIT_V(6); PG8_BAR;
    }
    for (;;) {
        const bool has_next = S.next(ui + 1, nxt);
        const char* nA = has_next ? (const char*)g.A + (size_t)nxt.pm * tstep : cA; const char* nB = has_next ? (const char*)g.Bt + (size_t)nxt.pn * tstep : cB;
        for (int t = 0; t < nt; t += 2) {
            const bool last = (t == nt - 2);
            const char* a1 = cA + (size_t)(t + 1) * kstep;
            const char* a2 = last ? nA : cA + (size_t)(t + 2) * kstep; const char* b2 = last ? nB : cB + (size_t)(t + 2) * kstep;
            const char* a3 = a2 + kstep; const char* b3 = b2 + kstep;
            if (last && has_next) S.a_ready(nxt);
            if constexpr (SP2) {
            PG8_LDB(B0, 0, 0); PG8_LDB(B1, 0, 1); PG8_SCHED; PG8_LDA(At, 0, 0); PG8_STAGE(PG8_SA(1, 1), a1 + hstep, voffA);
            PG8_WAIT_V(8); PG8_WAIT_L(0); PG8_BAR; PG8_MMA(0, 0, At, B0); PG8_MMA(0, 1, At, B1); PG8_BAR; PG8_SCHED;
            PG8_LDA(At, 0, 1); PG8_STAGE(PG8_SB(0, 0), b2, voffB); PG8_STAGE(PG8_SB(0, 1), b2 + hstep, voffB); PG8_STAGE(PG8_SA(0, 0), a2, voffA);
            PG8_WAIT_V(8); PG8_WAIT_L(0); PG8_BAR; PG8_MMA(1, 0, At, B0); PG8_MMA(1, 1, At, B1); PG8_BAR; PG8_SCHED;
            PG8_LDB(B0, 1, 0); PG8_LDB(B1, 1, 1); PG8_SCHED; PG8_LDA(At, 1, 0); PG8_STAGE(PG8_SA(0, 1), a2 + hstep, voffA);
            PG8_WAIT_V(8); PG8_WAIT_L(0); PG8_BAR; PG8_MMA(0, 0, At, B0); PG8_MMA(0, 1, At, B1); PG8_BAR; PG8_SCHED;
            PG8_LDA(At, 1, 1); PG8_STAGE(PG8_SB(1, 0), b3, voffB); PG8_STAGE(PG8_SB(1, 1), b3 + hstep, voffB); PG8_STAGE(PG8_SA(1, 0), a3, voffA);
            PG8_WAIT_V(8); PG8_WAIT_L(0); PG8_BAR; PG8_MMA(1, 0, At, B0); PG8_MMA(1, 1, At, B1); PG8_BAR; PG8_SCHED;
            } else {
            PG8_LDB(B0, 0, 0); PG8_SCHED; PG8_LDA(At, 0, 0); PG8_STAGE(PG8_SA(1, 1), a1 + hstep, voffA);
            PG8_WAIT_L(8); PG8_BAR; PG8_WAIT_L(0); PG8_MMA(0, 0, At, B0); PG8_BAR; PG8_SCHED;
            PG8_LDB(B1, 0, 1); PG8_STAGE(PG8_SB(0, 0), b2, voffB);
            PG8_BAR; PG8_WAIT_L(0); PG8_MMA(0, 1, At, B1); PG8_BAR;
            PG8_LDA(At, 0, 1); PG8_STAGE(PG8_SA(0, 0), a2, voffA);
            PG8_BAR; PG8_WAIT_L(0); PG8_MMA(1, 0, At, B0); PG8_BAR; PG8_SCHED;
            PG8_STAGE(PG8_SB(0, 1), b2 + hstep, voffB);
            PG8_WAIT_V(6); PG8_BAR; PG8_MMA(1, 1, At, B1); PG8_BAR;
            PG8_LDB(B0, 1, 0); PG8_SCHED; PG8_LDA(At, 1, 0); PG8_STAGE(PG8_SA(0, 1), a2 + hstep, voffA);
            PG8_WAIT_L(8); PG8_BAR; PG8_WAIT_L(0); PG8_MMA(0, 0, At, B0); PG8_BAR; PG8_SCHED;
            PG8_LDB(B1, 1, 1); PG8_STAGE(PG8_SB(1, 0), b3, voffB);
            PG8_BAR; PG8_WAIT_L(0); PG8_MMA(0, 1, At, B1); PG8_BAR;
            PG8_LDA(At, 1, 1); PG8_STAGE(PG8_SA(1, 0), a3, voffA);
            PG8_BAR; PG8_WAIT_L(0); PG8_MMA(1, 0, At, B0); PG8_BAR; PG8_SCHED;
            PG8_STAGE(PG8_SB(1, 1), b3 + hstep, voffB);
            PG8_WAIT_V(6); PG8_BAR; PG8_MMA(1, 1, At, B1); PG8_BAR;
            }
        }
        if constexpr (ALIGN_EPI) { if (wr == 0) PG8_BAR; }
        if constexpr (!Epi::AFTER_DRAIN) { E(acc, cur, wr, wc, fr, fq); S.done(cur); }
        if (!has_next) break;
#pragma unroll
        for (int a = 0; a < 2; ++a)
#pragma unroll
            for (int b = 0; b < 2; ++b)
#pragma unroll
                for (int m = 0; m < 4; ++m)
#pragma unroll
                    for (int n = 0; n < 2; ++n) acc[a][b][m][n] = (f32x4){0.f, 0.f, 0.f, 0.f};
        cur = nxt; cA = nA; cB = nB; ++ui;
        if constexpr (ALIGN_EPI) { if (wr == 1) PG8_BAR; }
    }
    PG8_WAIT_V(0);
    if constexpr (!ALIGN_EPI) { if (wr == 0) PG8_BAR; }
    PG8_BAR;
    if constexpr (Epi::AFTER_DRAIN) { E.fused(acc, cur, wr, wc, fr, fq, lds, wid, lane); S.done(cur); }
#undef PG8_SA
#undef PG8_SB
#undef PG8_STAGE
#undef PG8_LDA
#undef PG8_LDB
#undef PG8_MMA
#undef PG8_WAIT_V
#undef PG8_WAIT_L
#undef PG8_BAR
#undef PG8_SCHED
}
}

constexpr int NB = 8, SEQ = 2048, T = NB * SEQ, D = 2048, FF = 5632, NIN = 4352, NMOD = 9 * D;
constexpr float EPS = 1e-5f;
constexpr size_t MiB = 1u << 20;
constexpr size_t WS_WGU1 = 0, WS_WD1 = 44 * MiB, WS_WIN = 66 * MiB, WS_WOUT = 83 * MiB, WS_WGU2 = 91 * MiB, WS_WD2 = 135 * MiB;
constexpr size_t WS_MOD = 157 * MiB, WS_ROPE = 158 * MiB, WS_A = 159 * MiB, WS_R = 223 * MiB;
constexpr size_t WS_U = WS_R;
constexpr size_t WS_PROJ = WS_R, WS_OA = WS_R + 136 * MiB, WS_OB = WS_OA + 32 * MiB, WS_LSE = WS_OB + 96 * MiB, WS_CTL = WS_LSE + 3 * MiB, WS_XB = WS_CTL + 1 * MiB, WS_END = WS_XB + 64 * MiB;
constexpr int LDS_BYTES = 147456, NPH = 13;

#define LAS __attribute__((address_space(3)))
typedef unsigned short bf16;
typedef float f32x4 __attribute__((ext_vector_type(4)));
typedef float f32x16 __attribute__((ext_vector_type(16)));
typedef short bf16x8 __attribute__((ext_vector_type(8)));
typedef short s16x4 __attribute__((ext_vector_type(4)));
typedef unsigned u32x4 __attribute__((ext_vector_type(4)));
typedef unsigned u32x2 __attribute__((ext_vector_type(2)));
using pg8::cvt_pk_bf16;

__device__ __forceinline__ float wave_sum(float v) {
#pragma unroll
    for (int o = 1; o < 64; o <<= 1) v += __shfl_xor(v, o);
    return v;
}
__device__ __forceinline__ float bf_lo(unsigned w) { return __uint_as_float(w << 16); }
__device__ __forceinline__ float bf_hi(unsigned w) { return __uint_as_float(w & 0xffff0000u); }

struct Args { const float* in[20]; float* out; unsigned char* ws; float invf[8]; int ph_lo, ph_hi; };

struct TrItem { const float* W; bf16* WT; int K, N, mode, r; };
__device__ __forceinline__ void tr_load(const TrItem& t, f32x4 (&v)[16], int lane) {
    const int nblk = t.N / 64, kb = t.r / nblk, nb = t.r % nblk, k0 = 64 * kb, n0 = 64 * nb;
#pragma unroll
    for (int i = 0; i < 16; ++i) v[i] = __builtin_nontemporal_load((const f32x4*)(t.W + (size_t)(k0 + 4 * i + (lane >> 4)) * t.N + n0 + (lane & 15) * 4));
}
__device__ __forceinline__ void tr_lds_write(const f32x4 (&v)[16], LAS float* scr, int lane) {
#pragma unroll
    for (int i = 0; i < 16; ++i) { LAS float* s = scr + (4 * i + (lane >> 4)) * 65 + (lane & 15) * 4; s[0] = v[i][0]; s[1] = v[i][1]; s[2] = v[i][2]; s[3] = v[i][3]; }
}
__device__ __forceinline__ void tr_store(const TrItem& t, LAS float* scr, int lane) {
    const int nblk = t.N / 64, kb = t.r / nblk, nb = t.r % nblk, k0 = 64 * kb, n0 = 64 * nb;
    int drow0 = n0;
    if (t.mode == 1) { const int h = n0 >= FF ? 1 : 0, j = n0 - h * FF; drow0 = (j >> 7) * 256 + h * 128 + (j & 127); }
    const int c = lane & 7;
#pragma unroll
    for (int j = 0; j < 8; ++j) {
        const int n = (lane >> 3) + 8 * j; const LAS float* s = scr + (8 * c) * 65 + n;
        u32x4 o; o.x = cvt_pk_bf16(s[0], s[65]); o.y = cvt_pk_bf16(s[2 * 65], s[3 * 65]); o.z = cvt_pk_bf16(s[4 * 65], s[5 * 65]); o.w = cvt_pk_bf16(s[6 * 65], s[7 * 65]);
        *(u32x4*)(t.WT + (size_t)(drow0 + n) * t.K + k0 + 8 * c) = o;
    }
}
__device__ __forceinline__ void transpose_queue(const Args& a, LAS unsigned char* lds, int lane, int wave, int part) {
    unsigned char* ws = a.ws;
    LAS float* scr = (LAS float*)(lds + wave * 16640);
    unsigned* ctr = (unsigned*)(ws + WS_CTL) + 64 * part;
    constexpr int I_GU = (D / 64) * (2 * FF / 64), I_DN = (FF / 64) * (D / 64), I_IN = (D / 64) * (NIN / 64), I_OUT = (D / 64) * (D / 64);
    const int NITEMS = part == 0 ? I_GU + I_DN + I_IN + I_OUT : I_GU + I_DN;
    constexpr int CH = 8;
    static_assert(I_GU % CH == 0 && I_DN % CH == 0 && I_IN % CH == 0 && I_OUT % CH == 0, "chunks");
    auto decode = [&](int r) -> TrItem {
        if (part == 0) {
            if (r < I_GU) return TrItem{a.in[6], (bf16*)(ws + WS_WGU1), D, 2 * FF, 1, r}; r -= I_GU;
            if (r < I_DN) return TrItem{a.in[7], (bf16*)(ws + WS_WD1), FF, D, 0, r}; r -= I_DN;
            if (r < I_IN) return TrItem{a.in[9], (bf16*)(ws + WS_WIN), D, NIN, 0, r}; r -= I_IN;
            return TrItem{a.in[14], (bf16*)(ws + WS_WOUT), D, D, 0, r};
        }
        if (r < I_GU) return TrItem{a.in[17], (bf16*)(ws + WS_WGU2), D, 2 * FF, 1, r}; r -= I_GU;
        return TrItem{a.in[18], (bf16*)(ws + WS_WD2), FF, D, 0, r};
    };
    for (;;) {
        unsigned cidx = 0; if (lane == 0) cidx = atomicAdd(ctr, 1u);
        cidx = __builtin_amdgcn_readfirstlane(cidx);
        if (cidx * CH >= (unsigned)NITEMS) break;
        f32x4 v[16];
        TrItem cur = decode((int)cidx * CH);
        tr_load(cur, v, lane);
#pragma unroll
        for (int q = 0; q < CH; ++q) {
            tr_lds_write(v, scr, lane);
            TrItem nxt = cur;
            if (q + 1 < CH) { nxt = decode((int)cidx * CH + q + 1); tr_load(nxt, v, lane); }
            tr_store(cur, scr, lane);
            cur = nxt;
        }
    }
}

__device__ __forceinline__ void p0_prep(const Args& a, LAS unsigned char* lds, int tid, int lane, int wave, int G, int rep) {
    unsigned char* ws = a.ws;
    if (rep == 0) {
        const int* pos = (const int*)a.in[2]; float* tab = (float*)(ws + WS_ROPE);
        for (int tok = blockIdx.x * 512 + tid; tok < T; tok += G * 512) {
            const float pf = (float)pos[tok];
#pragma unroll
            for (int i = 0; i < 8; ++i) {
                const float ang = pf * a.invf[i];
                double rev = (double)ang * 0.15915494309189535; rev -= floor(rev);
                const float fr = (float)rev;
                tab[tok * 16 + i] = __builtin_amdgcn_cosf(fr); tab[tok * 16 + 8 + i] = __builtin_amdgcn_sinf(fr);
            }
        }
    }
    if (rep == 0) {
        LAS float* scT = (LAS float*)lds;
        LAS float* red = (LAS float*)(lds + 65536);
        const float* cc = a.in[1]; const float* Wa = a.in[3]; const float* ba = a.in[4]; float* mod = (float*)(ws + WS_MOD);
        for (int i = tid; i < NB * D; i += 512) { const int b = i / D, k = i % D; const float x = cc[i]; scT[k * 8 + b] = x / (1.0f + __expf(-x)); }
        __syncthreads();
        for (int it = blockIdx.x; it < NMOD / 64; it += G) {
            const int j = it * 64 + lane; const float* wp = Wa + (size_t)(wave * 256) * NMOD + j;
            float acc[8];
#pragma unroll
            for (int b = 0; b < 8; ++b) acc[b] = 0.f;
            for (int k0 = 0; k0 < 256; k0 += 32) {
                float w[32];
#pragma unroll
                for (int kk = 0; kk < 32; ++kk) w[kk] = __builtin_nontemporal_load(wp + (size_t)(k0 + kk) * NMOD);
#pragma unroll
                for (int kk = 0; kk < 32; ++kk) {
                    const LAS f32x4* sp = (const LAS f32x4*)(scT + (wave * 256 + k0 + kk) * 8);
                    const f32x4 s0 = sp[0], s1 = sp[1];
                    acc[0] += s0[0] * w[kk]; acc[1] += s0[1] * w[kk]; acc[2] += s0[2] * w[kk]; acc[3] += s0[3] * w[kk];
                    acc[4] += s1[0] * w[kk]; acc[5] += s1[1] * w[kk]; acc[6] += s1[2] * w[kk]; acc[7] += s1[3] * w[kk];
                }
            }
#pragma unroll
            for (int b = 0; b < 8; ++b) red[(wave * 8 + b) * 64 + lane] = acc[b];
            __syncthreads();
            { const int b = tid >> 6; float s = 0.f;
#pragma unroll
              for (int w = 0; w < 8; ++w) s += red[(w * 8 + b) * 64 + lane];
              mod[(size_t)b * NMOD + j] = s + ba[j]; }
            __syncthreads();
        }
    }
    __syncthreads();
    __syncthreads();
    transpose_queue(a, lds, lane, wave, 0);
}

template <bool IN_BF16>
__device__ __forceinline__ void norm_phase(const void* Xv, const float* g, const float* mod, int sub, bf16* outb, float* outf, int gw, int NGW, int lane) {
    for (int rb = gw; rb < T / 8; rb += NGW) {
        const int b = rb / (SEQ / 8);
        f32x4 A[8], S[8];
#pragma unroll
        for (int j = 0; j < 8; ++j) {
            const int c4 = (64 * j + lane) * 4;
            A[j] = *(const f32x4*)(g + c4);
            if (mod) { const float* mp = mod + (size_t)b * NMOD + (sub * 3) * D + c4; S[j] = *(const f32x4*)(mp); A[j] = A[j] * (*(const f32x4*)(mp + D) + 1.0f); }
            else S[j] = (f32x4){0.f, 0.f, 0.f, 0.f};
        }
        for (int r = 0; r < 8; ++r) {
            const size_t row = (size_t)rb * 8 + r;
            f32x4 v[8]; float ss = 0.f;
#pragma unroll
            for (int j = 0; j < 8; ++j) {
                if (IN_BF16) { const u32x2 w = *(const u32x2*)((const bf16*)Xv + row * D + (64 * j + lane) * 4); v[j] = (f32x4){bf_lo(w.x), bf_hi(w.x), bf_lo(w.y), bf_hi(w.y)}; }
                else v[j] = *(const f32x4*)((const float*)Xv + row * D + (64 * j + lane) * 4);
                ss += (v[j][0] * v[j][0] + v[j][1] * v[j][1]) + (v[j][2] * v[j][2] + v[j][3] * v[j][3]); }
            const float rstd = rsqrtf(wave_sum(ss) * (1.0f / D) + EPS);
#pragma unroll
            for (int j = 0; j < 8; ++j) {
                const f32x4 o = v[j] * rstd * A[j] + S[j];
                if (mod) { u32x2 w; w.x = cvt_pk_bf16(o[0], o[1]); w.y = cvt_pk_bf16(o[2], o[3]); *(u32x2*)(outb + row * D + (64 * j + lane) * 4) = w; }
                else *(f32x4*)(outf + row * D + (64 * j + lane) * 4) = o;
            }
        }
    }
}

__device__ __forceinline__ int att_off(int row, int ch) { const int a = (row >> 1) & 7, x = ((a & 1) << 2) | (a >> 1); return row * 128 + ((ch ^ x) << 4); }
__device__ __forceinline__ int crow(int r, int hi) { return (r & 3) + 8 * (r >> 2) + 4 * hi; }

struct AttUnit { int mode, type, head, dil, tok0, q0, qcol, kcol, vcol; };
__device__ __forceinline__ AttUnit att_decode_pair(int u) {
    AttUnit x; x.mode = 0; x.type = u >> 11; const int rem = u & 2047; x.head = rem & 15; const int qg = rem >> 4;
    x.dil = x.type <= 1 ? 1 : (x.type == 2 ? 4 : 16); const int nb = 16 / x.dil, seq = qg / nb, blk = qg % nb, b = seq / x.dil, rr = seq % x.dil;
    x.tok0 = b * SEQ + rr; x.q0 = blk * 128;
    x.qcol = 1280 + x.head * 64; x.kcol = 2304 + x.head * 64; x.vcol = 3328 + x.head * 64;
    return x;
}
__device__ __forceinline__ AttUnit att_decode_gqa(int g, int wave) {
    AttUnit x; x.mode = 1; x.type = 0; const int kvh = g & 1, qb = (g >> 1) & 63, b = g >> 7;
    x.head = 8 * kvh + wave; x.dil = 1; x.tok0 = b * SEQ; x.q0 = qb * 32;
    x.qcol = x.head * 64; x.kcol = 1024 + kvh * 64; x.vcol = 1152 + kvh * 64;
    return x;
}
__device__ __forceinline__ AttUnit att_decode_wide(int w) {
    AttUnit x; x.mode = 2; x.type = 1 + (w >> 10); const int rem = w & 1023; x.head = rem & 15; const int qg = rem >> 4;
    x.dil = x.type == 1 ? 1 : 4; const int nb = 8 / x.dil, seq = qg / nb, blk = qg % nb, b = seq / x.dil, rr = seq % x.dil;
    x.tok0 = b * SEQ + rr; x.q0 = blk * 256;
    x.qcol = 1280 + x.head * 64; x.kcol = 2304 + x.head * 64; x.vcol = 3328 + x.head * 64;
    return x;
}
__device__ __forceinline__ AttUnit att_unit_of(int it, int nG, int nW, int G, int half, int wave) {
    if (it < nG) return att_decode_gqa((int)blockIdx.x + it * G, wave);
    if (it < nG + nW) return att_decode_wide((int)blockIdx.x + (it - nG) * G);
    const int p = (int)blockIdx.x + (it - nG - nW) * G;
    return att_decode_pair(3 * 2048 + 2 * p + half);
}
__device__ __forceinline__ void att_issue(const bf16* P, const AttUnit& x, u32x4 (&kr)[8], u32x4 (&vr)[8], int tid, int htid) {
    const long vdelta = (long)(x.vcol - x.kcol) * 2;
    if (x.mode == 1) {
        const char* sb = (const char*)P + ((long)(x.tok0 + x.q0 - 128) * NIN + x.kcol) * 2;
        const unsigned voff = (unsigned)((tid >> 3) * NIN + (tid & 7) * 8) * 2u;
        const long istride = (long)64 * NIN * 2;
#pragma unroll
        for (int i = 0; i < 3; ++i) {
            if (i < 2 || tid < 256) { kr[i] = *(const u32x4*)(sb + i * istride + voff); vr[i] = *(const u32x4*)(sb + vdelta + i * istride + voff); }
            else { kr[i] = (u32x4){0u, 0u, 0u, 0u}; vr[i] = kr[i]; }
        }
#pragma unroll
        for (int i = 3; i < 8; ++i) { kr[i] = (u32x4){0u, 0u, 0u, 0u}; vr[i] = kr[i]; }
    } else if (x.mode == 2) {
        const char* sb = (const char*)P + ((long)(x.tok0 + (x.q0 - 128) * x.dil) * NIN + x.kcol) * 2;
        const unsigned voff = (unsigned)(((tid >> 3) * x.dil) * NIN + (tid & 7) * 8) * 2u;
        const long istride = (long)64 * x.dil * NIN * 2;
#pragma unroll
        for (int i = 0; i < 6; ++i) { kr[i] = *(const u32x4*)(sb + i * istride + voff); vr[i] = *(const u32x4*)(sb + vdelta + i * istride + voff); }
#pragma unroll
        for (int i = 6; i < 8; ++i) { kr[i] = (u32x4){0u, 0u, 0u, 0u}; vr[i] = kr[i]; }
    } else {
        const char* sb = (const char*)P + ((long)(x.tok0 + (x.q0 - 128) * x.dil) * NIN + x.kcol) * 2;
        const unsigned voff = (unsigned)(((htid >> 3) * x.dil) * NIN + (htid & 7) * 8) * 2u;
        const long istride = (long)32 * x.dil * NIN * 2;
        const bool skip4 = x.q0 == 0;
#pragma unroll
        for (int i = 0; i < 8; ++i) {
            if (i < 4 && skip4) { kr[i] = (u32x4){0u, 0u, 0u, 0u}; vr[i] = kr[i]; }
            else { kr[i] = *(const u32x4*)(sb + i * istride + voff); vr[i] = *(const u32x4*)(sb + vdelta + i * istride + voff); }
        }
    }
}
__device__ __forceinline__ void att_issue_q(const bf16* P, const AttUnit& x, bf16x8 (&qf)[4], int hw, int wave, int r32, int hi) {
    const int hwe = x.mode == 1 ? 0 : (x.mode == 2 ? wave : hw);
    const char* sq = (const char*)P + ((long)(x.tok0 + (x.q0 + 32 * hwe) * x.dil) * NIN + x.qcol) * 2;
    const unsigned qoff = (unsigned)((r32 * x.dil) * NIN + 8 * hi) * 2u;
#pragma unroll
    for (int s = 0; s < 4; ++s) qf[s] = *(const bf16x8*)(sq + 32 * s + qoff);
}

__device__ __forceinline__ void attn_phase(const Args& a, LAS unsigned char* lds, int tid, int lane, int wave, int G) {
    unsigned char* ws = a.ws;
    const bf16* P = (const bf16*)(ws + WS_PROJ);
    const int half = wave >> 2, hw = wave & 3, htid = tid & 255, r32 = lane & 31, hi = lane >> 5;
    LAS unsigned char* Kl = lds + half * 65536; LAS unsigned char* Vl = Kl + 32768;
    const float C2 = 0.125f * 1.4426950408889634f;
    const int blk16 = (lane >> 4) & 1, qq = (lane & 15) >> 2, pp = lane & 3;
    const int bx = (int)blockIdx.x;
    const int nG = bx < 1024 ? (1024 - 1 - bx) / G + 1 : 0, nW = bx < 2048 ? (2048 - 1 - bx) / G + 1 : 0, nP = bx < 1024 ? (1024 - 1 - bx) / G + 1 : 0, niter = nG + nW + nP;
    if (niter == 0) return;
    u32x4 kr[8], vr[8]; bf16x8 qn[4];
    AttUnit cur = att_unit_of(0, nG, nW, G, half, wave);
    att_issue(P, cur, kr, vr, tid, htid); att_issue_q(P, cur, qn, hw, wave, r32, hi);
    for (int it = 0; it < niter; ++it) {
        asm volatile("s_waitcnt lgkmcnt(0)\n\ts_barrier" ::: "memory");
        if (cur.mode == 1) {
#pragma unroll
            for (int i = 0; i < 3; ++i) { const int idx = i * 512 + tid, row = idx >> 3, ch = idx & 7; const int o = att_off(row, ch);
                if (i < 2 || tid < 256) { *(LAS u32x4*)(lds + o) = kr[i]; *(LAS u32x4*)(lds + 32768 + o) = vr[i]; } }
        } else if (cur.mode == 2) {
#pragma unroll
            for (int i = 0; i < 6; ++i) { const int idx = i * 512 + tid, row = idx >> 3, ch = idx & 7; const int o = att_off(row, ch); *(LAS u32x4*)(lds + o) = kr[i]; *(LAS u32x4*)(lds + 49152 + o) = vr[i]; }
        } else {
#pragma unroll
            for (int i = 0; i < 8; ++i) { const int idx = i * 256 + htid, row = idx >> 3, ch = idx & 7; const int o = att_off(row, ch); *(LAS u32x4*)(Kl + o) = kr[i]; *(LAS u32x4*)(Vl + o) = vr[i]; }
        }
        bf16x8 qf[4];
#pragma unroll
        for (int s = 0; s < 4; ++s) qf[s] = qn[s];
        asm volatile("s_waitcnt lgkmcnt(0)\n\ts_barrier" ::: "memory");
        const AttUnit x = cur;
        if (it + 1 < niter) { cur = att_unit_of(it + 1, nG, nW, G, half, wave); att_issue(P, cur, kr, vr, tid, htid); att_issue_q(P, cur, qn, hw, wave, r32, hi); }
        const int hwe = x.mode == 1 ? 0 : (x.mode == 2 ? wave : hw);
        LAS unsigned char* Kb = x.mode == 0 ? Kl : lds; LAS unsigned char* Vb = Kb + (x.mode == 2 ? 49152 : 32768);
        LAS unsigned char* kx[4]; LAS unsigned char* vx[2][2];
#pragma unroll
        for (int s = 0; s < 4; ++s) kx[s] = Kb + att_off(32 * hwe + r32, 2 * s + hi);
#pragma unroll
        for (int t = 0; t < 2; ++t)
#pragma unroll
            for (int c = 0; c < 2; ++c) vx[t][c] = Vb + att_off(32 * hwe + 4 * hi + qq + 8 * t, 4 * c + 2 * blk16 + (pp >> 1)) + 8 * (pp & 1);
        const int ql = 128 + 32 * hwe + r32;
        const int maxd = x.type == 0 ? 127 : 128;
        const float sink2 = x.type == 0 ? a.in[11][x.head] * 1.4426950408889634f : -INFINITY;
        float m = sink2, lsum = 0.f;
        f32x16 o[2]; o[0] = f32x16{}; o[1] = f32x16{};
#pragma unroll
        for (int ti = 4; ti >= 0; --ti) {
            const int tl = hwe + ti; const bool valid = (x.q0 - 128 + 32 * tl) >= 0;
            if (valid) {
                f32x16 acc = {};
#pragma unroll
                for (int s = 0; s < 4; ++s) { const bf16x8 kf = *(const LAS bf16x8*)(kx[s] + ti * 4096); acc = __builtin_amdgcn_mfma_f32_32x32x16_bf16(kf, qf[s], acc, 0, 0, 0); }
                float p[16]; float tmax = -INFINITY;
                if (ti == 4 || ti == 0) {
#pragma unroll
                    for (int r = 0; r < 16; ++r) { const int dd = ql - (32 * tl + crow(r, hi)); const bool ok = dd >= 0 && dd <= maxd; p[r] = ok ? acc[r] * C2 : -INFINITY; tmax = fmaxf(tmax, p[r]); }
                } else {
#pragma unroll
                    for (int r = 0; r < 16; ++r) { p[r] = acc[r] * C2; tmax = fmaxf(tmax, p[r]); }
                }
                tmax = fmaxf(tmax, __shfl_xor(tmax, 32));
                const float mnew = fmaxf(m, tmax);
                if (__any(mnew > m)) {
                    const float alpha = __builtin_amdgcn_exp2f(m - mnew);
                    lsum *= alpha;
#pragma unroll
                    for (int r = 0; r < 16; ++r) { o[0][r] *= alpha; o[1][r] *= alpha; }
                }
                m = mnew;
#pragma unroll
                for (int r = 0; r < 16; ++r) { p[r] = __builtin_amdgcn_exp2f(p[r] - mnew); lsum += p[r]; }
#pragma unroll
                for (int sp = 0; sp < 2; ++sp) {
                    u32x4 pw; pw.x = cvt_pk_bf16(p[8 * sp + 0], p[8 * sp + 1]); pw.y = cvt_pk_bf16(p[8 * sp + 2], p[8 * sp + 3]); pw.z = cvt_pk_bf16(p[8 * sp + 4], p[8 * sp + 5]); pw.w = cvt_pk_bf16(p[8 * sp + 6], p[8 * sp + 7]);
                    const bf16x8 pb = __builtin_bit_cast(bf16x8, pw);
#pragma unroll
                    for (int c = 0; c < 2; ++c) {
                        const s16x4 v0 = __builtin_bit_cast(s16x4, __builtin_amdgcn_ds_read_tr16_b64_v4i16((LAS s16x4*)(vx[0][c] + ti * 4096 + sp * 2048)));
                        const s16x4 v1 = __builtin_bit_cast(s16x4, __builtin_amdgcn_ds_read_tr16_b64_v4i16((LAS s16x4*)(vx[1][c] + ti * 4096 + sp * 2048)));
                        const bf16x8 vf = (bf16x8){v0[0], v0[1], v0[2], v0[3], v1[0], v1[1], v1[2], v1[3]};
                        o[c] = __builtin_amdgcn_mfma_f32_32x32x16_bf16(vf, pb, o[c], 0, 0, 0);
                    }
                }
            }
        }
        lsum += __shfl_xor(lsum, 32);
        if (x.type == 0) lsum += __builtin_amdgcn_exp2f(sink2 - m);
        const float inv = 1.0f / lsum;
        const size_t qtok = (size_t)(x.tok0 + (x.q0 + 32 * hwe + r32) * x.dil);
        bf16* outp = x.type == 0 ? (bf16*)(ws + WS_OA) : (bf16*)(ws + WS_OB) + (size_t)(x.type - 1) * T * 1024;
        bf16* op = outp + qtok * 1024 + x.head * 64 + 4 * hi;
#pragma unroll
        for (int c = 0; c < 2; ++c)
#pragma unroll
            for (int gq = 0; gq < 4; ++gq) { u32x2 w; w.x = cvt_pk_bf16(o[c][4 * gq] * inv, o[c][4 * gq + 1] * inv); w.y = cvt_pk_bf16(o[c][4 * gq + 2] * inv, o[c][4 * gq + 3] * inv); *(u32x2*)(op + 32 * c + 8 * gq) = w; }
        if (x.type != 0 && hi == 0) { float* lsep = (float*)(ws + WS_LSE) + (size_t)(x.type - 1) * T * 16; lsep[qtok * 16 + x.head] = (m + __log2f(lsum)) * 0.6931471805599453f; }
    }
}

__device__ __forceinline__ void combine_phase(const Args& a, int gw, int NGW, int lane) {
    unsigned char* ws = a.ws;
    const bf16* OA = (const bf16*)(ws + WS_OA); const bf16* OB = (const bf16*)(ws + WS_OB); const float* LSE = (const float*)(ws + WS_LSE); bf16* Y = (bf16*)(ws + WS_A);
    const float* ga = a.in[12] + 16 * lane; const float* gb = a.in[13] + 16 * lane;
    float GA[16], GB[16];
#pragma unroll
    for (int i = 0; i < 4; ++i) { const f32x4 x = *(const f32x4*)(ga + 4 * i), y = *(const f32x4*)(gb + 4 * i);
#pragma unroll
        for (int j = 0; j < 4; ++j) { GA[4 * i + j] = x[j]; GB[4 * i + j] = y[j]; } }
    for (int tok = gw; tok < T; tok += NGW) {
        float v[16];
        {
            const u32x4 w0 = *(const u32x4*)(OA + (size_t)tok * 1024 + 16 * lane), w1 = *(const u32x4*)(OA + (size_t)tok * 1024 + 16 * lane + 8);
#pragma unroll
            for (int i = 0; i < 4; ++i) { v[2 * i] = bf_lo(w0[i]); v[2 * i + 1] = bf_hi(w0[i]); v[8 + 2 * i] = bf_lo(w1[i]); v[8 + 2 * i + 1] = bf_hi(w1[i]); }
            float ss = 0.f;
#pragma unroll
            for (int i = 0; i < 16; ++i) ss += v[i] * v[i];
            const float rstd = rsqrtf(wave_sum(ss) * (1.0f / 1024.0f) + EPS);
            u32x4 o0, o1;
#pragma unroll
            for (int i = 0; i < 4; ++i) { o0[i] = cvt_pk_bf16(v[2 * i] * rstd * GA[2 * i], v[2 * i + 1] * rstd * GA[2 * i + 1]); o1[i] = cvt_pk_bf16(v[8 + 2 * i] * rstd * GA[8 + 2 * i], v[9 + 2 * i] * rstd * GA[9 + 2 * i]); }
            *(u32x4*)(Y + (size_t)tok * D + 16 * lane) = o0; *(u32x4*)(Y + (size_t)tok * D + 16 * lane + 8) = o1;
        }
        {
            const int h = lane >> 2;
            const float l0 = LSE[(size_t)tok * 16 + h], l1 = LSE[(size_t)T * 16 + (size_t)tok * 16 + h], l2 = LSE[(size_t)2 * T * 16 + (size_t)tok * 16 + h];
            const float m = fmaxf(l0, fmaxf(l1, l2)); float e0 = __expf(l0 - m), e1 = __expf(l1 - m), e2 = __expf(l2 - m); const float is = 1.0f / (e0 + e1 + e2);
            const float wgt[3] = {e0 * is, e1 * is, e2 * is};
#pragma unroll
            for (int i = 0; i < 16; ++i) v[i] = 0.f;
#pragma unroll
            for (int c = 0; c < 3; ++c) {
                const bf16* src = OB + (size_t)c * T * 1024 + (size_t)tok * 1024 + 16 * lane;
                const u32x4 w0 = *(const u32x4*)(src), w1 = *(const u32x4*)(src + 8);
#pragma unroll
                for (int i = 0; i < 4; ++i) { v[2 * i] += wgt[c] * bf_lo(w0[i]); v[2 * i + 1] += wgt[c] * bf_hi(w0[i]); v[8 + 2 * i] += wgt[c] * bf_lo(w1[i]); v[9 + 2 * i] += wgt[c] * bf_hi(w1[i]); }
            }
            float ss = 0.f;
#pragma unroll
            for (int i = 0; i < 16; ++i) ss += v[i] * v[i];
            const float rstd = rsqrtf(wave_sum(ss) * (1.0f / 1024.0f) + EPS);
            u32x4 o0, o1;
#pragma unroll
            for (int i = 0; i < 4; ++i) { o0[i] = cvt_pk_bf16(v[2 * i] * rstd * GB[2 * i], v[2 * i + 1] * rstd * GB[2 * i + 1]); o1[i] = cvt_pk_bf16(v[8 + 2 * i] * rstd * GB[8 + 2 * i], v[9 + 2 * i] * rstd * GB[9 + 2 * i]); }
            *(u32x4*)(Y + (size_t)tok * D + 1024 + 16 * lane) = o0; *(u32x4*)(Y + (size_t)tok * D + 1024 + 16 * lane + 8) = o1;
        }
    }
}

#define XB_TMO      128
#define XB_XCNT(j)  (256  + 64 * (j))
#define XB_XSUB(j)  (1280 + 64 * (j))
#define XB_XGEN(j)  (2304 + 64 * (j))
#define XB_TOP      3328
#define XB_TOPGEN   3392
#define XCD_BAR_WORDS 3456
#define XB_SPIN_CAP (1u << 24)

__device__ __forceinline__ unsigned xb_ld(unsigned* p)              { return __hip_atomic_load(p, __ATOMIC_RELAXED, __HIP_MEMORY_SCOPE_AGENT); }
__device__ __forceinline__ unsigned xb_add(unsigned* p, unsigned v) { return __hip_atomic_fetch_add(p, v, __ATOMIC_RELAXED, __HIP_MEMORY_SCOPE_AGENT); }
__device__ __forceinline__ unsigned xb_xcc_id() { return (unsigned)__builtin_amdgcn_s_getreg((3 << 11) | 20) & 0xFu; }
#define XB_SPIN(cond, bar) do { unsigned _sp = 0; while (cond) { __builtin_amdgcn_s_sleep(1); \
    if ((++_sp & 255u) == 0u) { if (xb_ld(&(bar)[XB_TMO])) break; if (_sp > XB_SPIN_CAP) { atomicAdd(&(bar)[XB_TMO], 1u); break; } } } } while (0)

struct XcdBarrier {
    unsigned* bar; unsigned x;
    volatile LAS unsigned* st;
};

__device__ __forceinline__ XcdBarrier xcd_barrier_post(unsigned* bar, volatile LAS unsigned* st) {
    XcdBarrier b; b.bar = bar; b.x = xb_xcc_id(); b.st = st;
    if (threadIdx.x == 0) (void)xb_add(&bar[XB_XCNT(b.x)], 1u);
    return b;
}
__device__ __forceinline__ void xcd_barrier_complete(unsigned* bar, unsigned x, unsigned& nloc, unsigned& nx) {
    const unsigned G = gridDim.x * gridDim.y * gridDim.z;
    unsigned sum, cnt, mine, sp = 0u;
    for (;;) {
        sum = 0u; cnt = 0u; mine = 0u;
#pragma unroll
        for (unsigned j = 0; j < 16; ++j) { const unsigned c = xb_ld(&bar[XB_XCNT(j)]); sum += c; cnt += (c > 0u) ? 1u : 0u; mine = (j == x) ? c : mine; }
        if (sum == G) break;
        __builtin_amdgcn_s_sleep(1);
        if ((++sp & 255u) == 0u) { if (xb_ld(&bar[XB_TMO])) break; if (sp > XB_SPIN_CAP) { atomicAdd(&bar[XB_TMO], 1u); break; } }
    }
    nloc = mine > 0u ? mine : 1u; nx = cnt > 0u ? cnt : 1u;
}

__device__ __forceinline__ void xcd_barrier(const XcdBarrier& b) {
    asm volatile("s_waitcnt vmcnt(0)" ::: "memory");
    __syncthreads();
    if (threadIdx.x == 0) {
        unsigned* bar = b.bar;
        __builtin_amdgcn_s_waitcnt(0);
        unsigned nloc = b.st[0], nx = b.st[1];
        if (nloc == 0u) { xcd_barrier_complete(bar, b.x, nloc, nx); b.st[0] = nloc; b.st[1] = nx; }
        const unsigned old = xb_add(&bar[XB_XSUB(b.x)], 1u);
        const unsigned gen = old / nloc;
        if (old + 1u == (gen + 1u) * nloc) {
            __builtin_amdgcn_fence(__ATOMIC_RELEASE, "agent");
            asm volatile("s_waitcnt vmcnt(0)" ::: "memory");
            const unsigned og = xb_add(&bar[XB_TOP], 1u);
            const unsigned tg = og / nx;
            if (og + 1u == (tg + 1u) * nx) xb_add(&bar[XB_TOPGEN], 1u);
            else XB_SPIN(xb_ld(&bar[XB_TOPGEN]) == tg, bar);
            __builtin_amdgcn_fence(__ATOMIC_ACQUIRE, "agent");
            xb_add(&bar[XB_XGEN(b.x)], 1u);
            asm volatile("s_waitcnt vmcnt(0)" ::: "memory");
        } else {
            XB_SPIN(xb_ld(&bar[XB_XGEN(b.x)]) == gen, bar);
            __builtin_amdgcn_fence(__ATOMIC_ACQUIRE, "agent");
            asm volatile("s_waitcnt vmcnt(0)" ::: "memory");
        }
    }
    __syncthreads();
}


__global__ void __launch_bounds__(512, 2) mk_fwd(Args a) {
    extern __shared__ __attribute__((aligned(16))) unsigned char lds_raw[];
    LAS unsigned char* lds = (LAS unsigned char*)lds_raw;
    const int tid = threadIdx.x, lane = tid & 63, wave = __builtin_amdgcn_readfirstlane(tid >> 6);
    const int G = gridDim.x, gw = blockIdx.x * 8 + wave, NGW = G * 8;
    unsigned char* ws = a.ws;
    bf16* Abuf = (bf16*)(ws + WS_A); bf16* U = (bf16*)(ws + WS_U); bf16* XB = (bf16*)(ws + WS_XB); const float* mod = (const float*)(ws + WS_MOD);
#ifndef PHM
#define PHM 0xffff
#endif
#define HAS(k) ((PHM >> (k)) & 1)
    const int lo = a.ph_lo, hi = a.ph_hi;
    volatile LAS unsigned* MISC = (volatile LAS unsigned*)(lds + LDS_BYTES - 256);
    if (tid < 64) MISC[tid] = 0u;
    __syncthreads();
    XcdBarrier xbar; xbar.bar = (unsigned*)(ws + WS_CTL + 16384); xbar.x = 0; xbar.st = nullptr;
    if (hi - lo > 1) xbar = xcd_barrier_post((unsigned*)(ws + WS_CTL + 16384), MISC + 8);
#ifndef REPM
#define REPM 0
#endif
#define REP(k) (((REPM >> (k)) & 1) ? 2 : 1)
#define IN(k) (HAS(k) && lo <= (k) && (k) < hi)
#define SEAM(k) do { if ((k) + 1 < hi && lo <= (k)) { xcd_barrier(xbar); } } while (0)
#define NORM_PH(k, BF, Xp, gp, sub) if (IN(k)) for (int rep_ = 0; rep_ < REP(k); ++rep_) { norm_phase<BF>(Xp, gp, mod, sub, Abuf, nullptr, gw, NGW, lane); } SEAM(k)
#define SWIGLU_PH(k, WOFF) if (IN(k)) for (int rep_ = 0; rep_ < REP(k); ++rep_) { pg8::Gemm g{Abuf, (const bf16*)(ws + (WOFF)), T, 2 * FF, D}; pg8::StaticOrder S; S.init(T, 2 * FF, G, (int)blockIdx.x); \
        pg8::EpiSwiglu E{U, FF}; pg8::gemm_phase<pg8::EpiSwiglu, pg8::StaticOrder, GEMM_ALIGN, GEMM_SP2>(lds, g, S, E); } SEAM(k)
#define RESID_PH(k, BF, Ap, WOFF, KK, basep, biasp, sub, gs) if (IN(k)) for (int rep_ = 0; rep_ < REP(k); ++rep_) { pg8::Gemm g{Ap, (const bf16*)(ws + (WOFF)), T, D, KK}; pg8::StaticOrder S; S.init(T, D, G, (int)blockIdx.x); \
        pg8::EpiResid<BF> E{basep, XB, biasp, mod + ((sub) * 3 + 2) * D, gs, D, NMOD}; pg8::gemm_phase<pg8::EpiResid<BF>, pg8::StaticOrder, GEMM_ALIGN, GEMM_SP2>(lds, g, S, E); } SEAM(k)
    if (hi > 1000) cg::this_grid().sync();
    if (IN(0)) for (int rep_ = 0; rep_ < REP(0); ++rep_) { p0_prep(a, lds, tid, lane, wave, G, rep_); __syncthreads(); }
    SEAM(0);
    NORM_PH(1, false, a.in[0], a.in[5], 0);
    SWIGLU_PH(2, WS_WGU1);
    RESID_PH(3, false, U, WS_WD1, FF, a.in[0], nullptr, 0, 0.5f);
    NORM_PH(4, true, XB, a.in[8], 1);
    if (IN(5)) for (int rep_ = 0; rep_ < REP(5); ++rep_) {
        pg8::Gemm g{Abuf, (const bf16*)(ws + WS_WIN), T, NIN, D}; pg8::StaticOrder S; S.init(T, NIN, G, (int)blockIdx.x);
        pg8::EpiQKV E{(bf16*)(ws + WS_PROJ), a.in[10], (const float*)(ws + WS_ROPE), NIN};
        pg8::gemm_phase<pg8::EpiQKV, pg8::StaticOrder, GEMM_ALIGN, GEMM_SP2>(lds, g, S, E);
        __syncthreads();
        transpose_queue(a, lds, lane, wave, 1);
    }
    SEAM(5);
    if (IN(6)) for (int rep_ = 0; rep_ < REP(6); ++rep_) attn_phase(a, lds, tid, lane, wave, G);
    SEAM(6);
    if (IN(7)) for (int rep_ = 0; rep_ < REP(7); ++rep_) combine_phase(a, gw, NGW, lane);
    SEAM(7);
    RESID_PH(8, true, Abuf, WS_WOUT, D, XB, a.in[15], 1, 1.0f);
    NORM_PH(9, true, XB, a.in[16], 2);
    SWIGLU_PH(10, WS_WGU2);
    RESID_PH(11, true, U, WS_WD2, FF, XB, nullptr, 2, 0.5f);
    if (IN(12)) norm_phase<true>(XB, a.in[19], nullptr, 0, nullptr, a.out, gw, NGW, lane);
}

extern "C" void kernel_launch(void* const* d_in, const int* in_sizes, int n_in, void* d_out, int out_size, void* d_ws, size_t ws_size, hipStream_t stream) {
    static int grid = 0;
    if (grid == 0) {
        if (n_in != 20 || in_sizes[0] != T * D || out_size != T * D || ws_size < WS_END) { fprintf(stderr, "kernel_launch: unexpected shapes / workspace (n_in %d, in0 %d, out %d, ws %zu < %zu)\n", n_in, n_in > 0 ? in_sizes[0] : -1, out_size, ws_size, (size_t)WS_END); grid = -1; return; }
        int dev = 0, cus = 0, per_cu = 0;
        if (hipGetDevice(&dev) != hipSuccess || hipDeviceGetAttribute(&cus, hipDeviceAttributeMultiprocessorCount, dev) != hipSuccess) { grid = -1; return; }
        if (hipFuncSetAttribute((const void*)mk_fwd, hipFuncAttributeMaxDynamicSharedMemorySize, LDS_BYTES) != hipSuccess) { fprintf(stderr, "kernel_launch: hipFuncSetAttribute failed\n"); grid = -1; return; }
        if (hipOccupancyMaxActiveBlocksPerMultiprocessor(&per_cu, (const void*)mk_fwd, 512, LDS_BYTES) != hipSuccess || per_cu < 1) { fprintf(stderr, "kernel_launch: occupancy query says %d\n", per_cu); per_cu = 1; }
        (void)hipGetLastError();
        grid = cus * per_cu;
    }
    if (grid < 0) return;
    (void)hipMemsetAsync((char*)d_ws + WS_CTL, 0, 65536, stream);
    Args a{};
    for (int i = 0; i < 20; ++i) a.in[i] = (const float*)d_in[i];
    a.out = (float*)d_out; a.ws = (unsigned char*)d_ws;
    for (int i = 0; i < 8; ++i) a.invf[i] = powf(500000.0f, -((float)(2 * i) / 16.0f));
#if MK_MULTI
#ifndef DBG_LAST
#define DBG_LAST (NPH - 1)
#endif
    for (int ph = 0; ph <= DBG_LAST; ++ph) {
#ifdef DBG_SKIP
        if ((DBG_SKIP >> ph) & 1) continue;
#endif
        a.ph_lo = ph; a.ph_hi = ph + 1; hipLaunchKernelGGL(mk_fwd, dim3(grid), dim3(512), LDS_BYTES, stream, a); }
#else
    a.ph_lo = 0; a.ph_hi = NPH;
    void* args[] = {&a};
    hipError_t e = hipLaunchCooperativeKernel((const void*)mk_fwd, dim3(grid), dim3(512), args, LDS_BYTES, stream);
    if (e != hipSuccess) fprintf(stderr, "cooperative launch failed: %s (grid %d)\n", hipGetErrorString(e), grid);
#endif
}
```

```cpp
#include <hip/hip_runtime.h>
#include <hip/hip_cooperative_groups.h>
#include <cstdio>
#include <cstdint>
#include <cmath>
namespace cg = cooperative_groups;
#ifndef MK_MULTI
#define MK_MULTI 0
#ifndef GEMM_ALIGN
#define GEMM_ALIGN true
#endif
#ifndef GEMM_SP2
#define GEMM_SP2 true
#endif
#endif
namespace pg8 {
#define PG8_LAS __attribute__((address_space(3)))
typedef unsigned short bf16_t;
typedef short bf16x8 __attribute__((ext_vector_type(8)));
typedef float f32x4 __attribute__((ext_vector_type(4)));
typedef unsigned u32x4 __attribute__((ext_vector_type(4)));
constexpr int BM = 256, BK = 64, HALF = 128, HTB = HALF * BK * 2  , STAGE_BYTES = 8 * HTB, NXCD = 8, WGM = 8;

__host__ __device__ __forceinline__ int lds_byte(int r, int c) { const int st = (r >> 4) * 2 + (c >> 5), rr = r & 15, cc = c & 31, ob = rr * 64 + cc * 2; return st * 1024 + (ob ^ (((ob >> 9) & 1) << 5)); }
__host__ __device__ __forceinline__ void stage_rc(int b, int& R, int& C) { const int st = b / 1024, sb = b % 1024, swz = sb ^ (((sb >> 9) & 1) << 5); R = (st >> 1) * 16 + swz / 64; C = (st & 1) * 32 + (swz % 64) / 2; }
__host__ __device__ __forceinline__ int perm32(int rho) { const int n = rho >> 4, i = rho & 15; return 8 * (i >> 2) + 4 * n + (i & 3); }

struct Unit { int pm, pn; };
struct Gemm { const bf16_t* A; const bf16_t* Bt; int M, N, K; };

struct StaticOrder {
    int nM, nN, nwg, G, c;
    __host__ __device__ void init(int M, int N, int G_, int c_) { nM = M / BM; nN = N / BM; nwg = nM * nN; G = G_; c = c_; }
    __host__ __device__ bool next(int i, Unit& u) const {
        const long L = (long)i * G + c; if (L >= nwg) return false;
        int wgid = (int)L; { const int q = nwg / NXCD, r = nwg % NXCD, xcd = wgid % NXCD, off = wgid / NXCD; wgid = (xcd < r ? xcd * (q + 1) : r * (q + 1) + (xcd - r) * q) + off; }
        const int nig = WGM * nN, gid = wgid / nig, fm = gid * WGM, gsz = (nM - fm) < WGM ? (nM - fm) : WGM;
        u.pm = fm + ((wgid % nig) % gsz); u.pn = (wgid % nig) / gsz; return true;
    }
    __device__ __forceinline__ void a_ready(const Unit&) const {}
    __device__ __forceinline__ void done(const Unit&) const {}
};

typedef float f32x2_t __attribute__((ext_vector_type(2))); typedef __bf16 bf16x2_t __attribute__((ext_vector_type(2)));
__device__ __forceinline__ unsigned cvt_pk_bf16(float lo, float hi) { f32x2_t v = {lo, hi}; bf16x2_t b = __builtin_convertvector(v, bf16x2_t); return __builtin_bit_cast(unsigned, b); }
__device__ __forceinline__ float silu_mul(float g, float u) { return g * u * __builtin_amdgcn_rcpf(1.0f + __builtin_amdgcn_exp2f(-1.4426950408889634f * g)); }

struct EpiSwiglu {
    static constexpr bool PERM = true, AFTER_DRAIN = false;
    bf16_t* O; int ldo;
    __device__ __forceinline__ void operator()(const f32x4 (&acc)[2][2][4][2], const Unit& u, int wr, int wc, int fr, int fq) const {
        const int row0 = u.pm * BM + wr * 64 + fr, col0 = u.pn * HALF + wc * 32 + 8 * fq;
#ifdef PROBE_SWEPI2
      for (int rp_ = 0; rp_ < 2; ++rp_) { asm volatile("" ::: "memory");
#endif
#pragma unroll
        for (int ai = 0; ai < 2; ++ai)
#pragma unroll
            for (int m = 0; m < 4; ++m) {
                bf16_t* p = O + (size_t)(row0 + ai * HALF + m * 16) * ldo + col0;
                const f32x4 g0 = acc[ai][0][m][0], g1 = acc[ai][0][m][1], u0 = acc[ai][1][m][0], u1 = acc[ai][1][m][1];
                u32x4 w;
                w.x = cvt_pk_bf16(silu_mul(g0[0], u0[0]), silu_mul(g0[1], u0[1]));
                w.y = cvt_pk_bf16(silu_mul(g0[2], u0[2]), silu_mul(g0[3], u0[3]));
                w.z = cvt_pk_bf16(silu_mul(g1[0], u1[0]), silu_mul(g1[1], u1[1]));
                w.w = cvt_pk_bf16(silu_mul(g1[2], u1[2]), silu_mul(g1[3], u1[3]));
                *(u32x4*)p = w;
            }
#ifdef PROBE_SWEPI2
      }
#endif
    }
};

template <bool BASE_BF16> struct EpiResid {
    static constexpr bool PERM = true, AFTER_DRAIN = false;
    const void* base; bf16_t* out; const float* bias; const float* gatev; float gs; int ldc, gstride;
    __device__ __forceinline__ void operator()(const f32x4 (&acc)[2][2][4][2], const Unit& u, int wr, int wc, int fr, int fq) const {
        const float* gp = gatev + (size_t)(u.pm >> 3) * gstride;
        const int row0 = u.pm * BM + wr * 64 + fr;
#pragma unroll
        for (int bj = 0; bj < 2; ++bj) {
            const int col0 = u.pn * BM + bj * HALF + wc * 32 + 8 * fq;
            const f32x4 g0 = *(const f32x4*)(gp + col0) * gs, g1 = *(const f32x4*)(gp + col0 + 4) * gs;
            const f32x4 b0 = bias ? *(const f32x4*)(bias + col0) : (f32x4){0.f, 0.f, 0.f, 0.f}, b1 = bias ? *(const f32x4*)(bias + col0 + 4) : (f32x4){0.f, 0.f, 0.f, 0.f};
#pragma unroll
            for (int ai = 0; ai < 2; ++ai)
#pragma unroll
                for (int m = 0; m < 4; ++m) {
                    const size_t off = (size_t)(row0 + ai * HALF + m * 16) * ldc + col0;
                    f32x4 s0, s1;
                    if (BASE_BF16) { const u32x4 w = *(const u32x4*)((const bf16_t*)base + off);
                        s0 = (f32x4){__uint_as_float(w.x << 16), __uint_as_float(w.x & 0xffff0000u), __uint_as_float(w.y << 16), __uint_as_float(w.y & 0xffff0000u)};
                        s1 = (f32x4){__uint_as_float(w.z << 16), __uint_as_float(w.z & 0xffff0000u), __uint_as_float(w.w << 16), __uint_as_float(w.w & 0xffff0000u)}; }
                    else { s0 = *(const f32x4*)((const float*)base + off); s1 = *(const f32x4*)((const float*)base + off + 4); }
                    const f32x4 v0 = s0 + g0 * (acc[ai][bj][m][0] + b0), v1 = s1 + g1 * (acc[ai][bj][m][1] + b1);
                    u32x4 w; w.x = cvt_pk_bf16(v0[0], v0[1]); w.y = cvt_pk_bf16(v0[2], v0[3]); w.z = cvt_pk_bf16(v1[0], v1[1]); w.w = cvt_pk_bf16(v1[2], v1[3]);
                    *(u32x4*)(out + off) = w;
                }
        }
    }
};

struct EpiQKV {
    static constexpr bool PERM = true, AFTER_DRAIN = false;
    bf16_t* O; const float* bias; const float* rope; int ldo;
    __device__ __forceinline__ void operator()(const f32x4 (&acc)[2][2][4][2], const Unit& u, int wr, int wc, int fr, int fq) const {
        const int row0 = u.pm * BM + wr * 64 + fr;
#pragma unroll
        for (int bj = 0; bj < 2; ++bj) {
            const int ch = u.pn * BM + bj * HALF;
            const bool rope_on = ((ch < 1152) || (ch >= 1280 && ch < 3328)) && ((wc & 1) == 0);
            const int col0 = ch + wc * 32 + 8 * fq;
            const f32x4 b0 = *(const f32x4*)(bias + col0), b1 = *(const f32x4*)(bias + col0 + 4);
#pragma unroll
            for (int ai = 0; ai < 2; ++ai)
#pragma unroll
                for (int m = 0; m < 4; ++m) {
                    const int row = row0 + ai * HALF + m * 16;
                    f32x4 x0 = acc[ai][bj][m][0] + b0, x1 = acc[ai][bj][m][1] + b1;
                    if (rope_on) {
                        f32x4 y0, y1;
#pragma unroll
                        for (int i = 0; i < 4; ++i) { y0[i] = __shfl_xor(x0[i], 16); y1[i] = __shfl_xor(x1[i], 16); }
                        if (fq < 2) {
                            const float* rp = rope + (size_t)row * 16;
                            const f32x4 c0 = *(const f32x4*)(rp), c1 = *(const f32x4*)(rp + 4), s0 = *(const f32x4*)(rp + 8), s1 = *(const f32x4*)(rp + 12);
                            if (fq == 0) { x0 = x0 * c0 - y0 * s0; x1 = x1 * c1 - y1 * s1; }
                            else         { x0 = x0 * c0 + y0 * s0; x1 = x1 * c1 + y1 * s1; }
                        }
                    }
                    u32x4 w; w.x = cvt_pk_bf16(x0[0], x0[1]); w.y = cvt_pk_bf16(x0[2], x0[3]); w.z = cvt_pk_bf16(x1[0], x1[1]); w.w = cvt_pk_bf16(x1[2], x1[3]);
                    *(u32x4*)(O + (size_t)row * ldo + col0) = w;
                }
        }
    }
};

template <class Epi, class Sched, bool ALIGN_EPI = false, bool SP2 = false>
__device__ __forceinline__ void gemm_phase(PG8_LAS unsigned char* lds, const Gemm g, const Sched& S, const Epi& E) {
    const int tid = threadIdx.x, wid = __builtin_amdgcn_readfirstlane(tid >> 6), lane = tid & 63, wr = wid >> 2, wc = wid & 3, fr = lane & 15, fq = lane >> 4;
    const int K = g.K, nt = K / BK;
    unsigned voffA[2], voffB[2];
#pragma unroll
    for (int i = 0; i < 2; ++i) { int R, C; stage_rc(tid * 16 + i * 8192, R, C); const int Rb = Epi::PERM ? ((R & ~31) + perm32(R & 31)) : R;
        voffA[i] = (unsigned)(R * K + C) * 2u; voffB[i] = (unsigned)(Rb * K + C) * 2u; }
    const size_t kstep = (size_t)(BK * 2);
    const size_t hstep = (size_t)HALF * K * 2;
    const size_t tstep = 2 * hstep;
    const unsigned ldsw = (unsigned)wid * 1024u;
    const int aoff = lds_byte(wr * 64 + fr, fq * 8), boff = lds_byte(wc * 32 + fr, fq * 8);
#define PG8_SA(b, h) (((b) * 2 + (h)) * HTB)
#define PG8_SB(b, h) ((4 + (b) * 2 + (h)) * HTB)
#define PG8_STAGE(bufoff, gbase, voff) do { _Pragma("unroll") for (int _i = 0; _i < 2; ++_i) \
        __builtin_amdgcn_global_load_lds((const unsigned*)((const char*)(gbase) + (voff)[_i]), (PG8_LAS unsigned*)(lds + (bufoff) + ldsw + _i * 8192), 16, 0, 0); } while (0)
#define PG8_LDA(dst, b, h) do { _Pragma("unroll") for (int m = 0; m < 4; ++m) _Pragma("unroll") for (int k = 0; k < 2; ++k) dst[m][k] = *(const PG8_LAS bf16x8*)(lds + PG8_SA(b, h) + aoff + m * 2048 + k * 1024); } while (0)
#define PG8_LDB(dst, b, h) do { _Pragma("unroll") for (int n = 0; n < 2; ++n) _Pragma("unroll") for (int k = 0; k < 2; ++k) dst[n][k] = *(const PG8_LAS bf16x8*)(lds + PG8_SB(b, h) + boff + n * 2048 + k * 1024); } while (0)
#define PG8_MMA(ai, bj, At, Bt) do { __builtin_amdgcn_s_setprio(1); _Pragma("unroll") for (int m = 0; m < 4; ++m) _Pragma("unroll") for (int n = 0; n < 2; ++n) _Pragma("unroll") for (int k = 0; k < 2; ++k) \
        acc[ai][bj][m][n] = __builtin_amdgcn_mfma_f32_16x16x32_bf16(Bt[n][k], At[m][k], acc[ai][bj][m][n], 0, 0, 0); __builtin_amdgcn_s_setprio(0); } while (0)
#define PG8_WAIT_V(n) asm volatile("s_waitcnt vmcnt(" #n ")" ::: "memory")
#define PG8_WAIT_L(n) asm volatile("s_waitcnt lgkmcnt(" #n ")" ::: "memory")
#define PG8_BAR __builtin_amdgcn_s_barrier()
#define PG8_SCHED __builtin_amdgcn_sched_barrier(0)
    Unit cur, nxt; int ui = 0;
    if (!S.next(0, cur)) return;
    f32x4 acc[2][2][4][2];
#pragma unroll
    for (int a = 0; a < 2; ++a)
#pragma unroll
        for (int b = 0; b < 2; ++b)
#pragma unroll
            for (int m = 0; m < 4; ++m)
#pragma unroll
                for (int n = 0; n < 2; ++n) acc[a][b][m][n] = (f32x4){0.f, 0.f, 0.f, 0.f};
    bf16x8 At[4][2], B0[2][2], B1[2][2];
    const char* cA = (const char*)g.A + (size_t)cur.pm * tstep; const char* cB = (const char*)g.Bt + (size_t)cur.pn * tstep;
    S.a_ready(cur);
    if constexpr (SP2) {
        PG8_STAGE(PG8_SB(0, 0), cB, voffB); PG8_STAGE(PG8_SB(0, 1), cB + hstep, voffB); PG8_STAGE(PG8_SA(0, 0), cA, voffA); PG8_STAGE(PG8_SA(0, 1), cA + hstep, voffA);
        if (wr == 1) PG8_BAR;
        PG8_WAIT_V(2); PG8_BAR;
        PG8_STAGE(PG8_SB(1, 0), cB + kstep, voffB); PG8_STAGE(PG8_SA(1, 0), cA + kstep, voffA); PG8_STAGE(PG8_SB(1, 1), cB + hstep + kstep, voffB);
        PG8_WAIT_V(6); PG8_BAR;
    } else {
        PG8_STAGE(PG8_SB(0, 0), cB, voffB); PG8_STAGE(PG8_SA(0, 0), cA, voffA); PG8_STAGE(PG8_SB(0, 1), cB + hstep, voffB); PG8_STAGE(PG8_SA(0, 1), cA + hstep, voffA);
        if (wr == 1) PG8_BAR;
        PG8_WAIT_V(4); PG8_BAR;
        PG8_STAGE(PG8_SB(1, 0), cB + kstep, voffB); PG8_STAGE(PG8_SA(1, 0), cA + kstep, voffA); PG8_STAGE(PG8_SB(1, 1), cB + hstep + kstep, voffB);
        PG8_WAIT_V(6); PG8_BAR;
    }
    for (;;) {
        const bool has_next = S.next(ui + 1, nxt);
        const char* nA = has_next ? (const char*)g.A + (size_t)nxt.pm * tstep : cA; const char* nB = has_next ? (const char*)g.Bt + (size_t)nxt.pn * tstep : cB;
        for (int t = 0; t < nt; t += 2) {
            const bool last = (t == nt - 2);
            const char* a1 = cA + (size_t)(t + 1) * kstep;
            const char* a2 = last ? nA : cA + (size_t)(t + 2) * kstep; const char* b2 = last ? nB : cB + (size_t)(t + 2) * kstep;
            const char* a3 = a2 + kstep; const char* b3 = b2 + kstep;
            if (last && has_next) S.a_ready(nxt);
            if constexpr (SP2) {
            PG8_LDB(B0, 0, 0); PG8_LDB(B1, 0, 1); PG8_SCHED; PG8_LDA(At, 0, 0); PG8_STAGE(PG8_SA(1, 1), a1 + hstep, voffA);
            PG8_WAIT_V(8); PG8_WAIT_L(0); PG8_BAR; PG8_MMA(0, 0, At, B0); PG8_MMA(0, 1, At, B1); PG8_BAR; PG8_SCHED;
            PG8_LDA(At, 0, 1); PG8_STAGE(PG8_SB(0, 0), b2, voffB); PG8_STAGE(PG8_SB(0, 1), b2 + hstep, voffB); PG8_STAGE(PG8_SA(0, 0), a2, voffA);
            PG8_WAIT_V(8); PG8_WAIT_L(0); PG8_BAR; PG8_MMA(1, 0, At, B0); PG8_MMA(1, 1, At, B1); PG8_BAR; PG8_SCHED;
            PG8_LDB(B0, 1, 0); PG8_LDB(B1, 1, 1); PG8_SCHED; PG8_LDA(At, 1, 0); PG8_STAGE(PG8_SA(0, 1), a2 + hstep, voffA);
            PG8_WAIT_V(8); PG8_WAIT_L(0); PG8_BAR; PG8_MMA(0, 0, At, B0); PG8_MMA(0, 1, At, B1); PG8_BAR; PG8_SCHED;
            PG8_LDA(At, 1, 1); PG8_STAGE(PG8_SB(1, 0), b3, voffB); PG8_STAGE(PG8_SB(1, 1), b3 + hstep, voffB); PG8_STAGE(PG8_SA(1, 0), a3, voffA);
            PG8_WAIT_V(8); PG8_WAIT_L(0); PG8_BAR; PG8_MMA(1, 0, At, B0); PG8_MMA(1, 1, At, B1); PG8_BAR; PG8_SCHED;
            } else {
            PG8_LDB(B0, 0, 0); PG8_SCHED; PG8_LDA(At, 0, 0); PG8_STAGE(PG8_SA(1, 1), a1 + hstep, voffA);
            PG8_WAIT_L(8); PG8_BAR; PG8_WAIT_L(0); PG8_MMA(0, 0, At, B0); PG8_BAR; PG8_SCHED;
            PG8_LDB(B1, 0, 1); PG8_STAGE(PG8_SB(0, 0), b2, voffB);
            PG8_BAR; PG8_WAIT_L(0); PG8_MMA(0, 1, At, B1); PG8_BAR;
            PG8_LDA(At, 0, 1); PG8_STAGE(PG8_SA(0, 0), a2, voffA);
            PG8_BAR; PG8_WAIT_L(0); PG8_MMA(1, 0, At, B0); PG8_BAR; PG8_SCHED;
            PG8_STAGE(PG8_SB(0, 1), b2 + hstep, voffB);
            PG8_WAIT_V(6); PG8_BAR; PG8_MMA(1, 1, At, B1); PG8_BAR;
            PG8_LDB(B0, 1, 0); PG8_SCHED; PG8_LDA(At, 1, 0); PG8_STAGE(PG8_SA(0, 1), a2 + hstep, voffA);
            PG8_WAIT_L(8); PG8_BAR; PG8_WAIT_L(0); PG8_MMA(0, 0, At, B0); PG8_BAR; PG8_SCHED;
            PG8_LDB(B1, 1, 1); PG8_STAGE(PG8_SB(1, 0), b3, voffB);
            PG8_BAR; PG8_WAIT_L(0); PG8_MMA(0, 1, At, B1); PG8_BAR;
            PG8_LDA(At, 1, 1); PG8_STAGE(PG8_SA(1, 0), a3, voffA);
            PG8_BAR; PG8_WAIT_L(0); PG8_MMA(1, 0, At, B0); PG8_BAR; PG8_SCHED;
            PG8_STAGE(PG8_SB(1, 1), b3 + hstep, voffB);
            PG8_WAIT_V(6); PG8_BAR; PG8_MMA(1, 1, At, B1); PG8_BAR;
            }
        }
        if constexpr (ALIGN_EPI) { if (wr == 0) PG8_BAR; }
        if constexpr (!Epi::AFTER_DRAIN) { E(acc, cur, wr, wc, fr, fq); S.done(cur); }
        if (!has_next) break;
#pragma unroll
        for (int a = 0; a < 2; ++a)
#pragma unroll
            for (int b = 0; b < 2; ++b)
#pragma unroll
                for (int m = 0; m < 4; ++m)
#pragma unroll
                    for (int n = 0; n < 2; ++n) acc[a][b][m][n] = (f32x4){0.f, 0.f, 0.f, 0.f};
        cur = nxt; cA = nA; cB = nB; ++ui;
        if constexpr (ALIGN_EPI) { if (wr == 1) PG8_BAR; }
    }
    PG8_WAIT_V(0);
    if constexpr (!ALIGN_EPI) { if (wr == 0) PG8_BAR; }
    PG8_BAR;
    if constexpr (Epi::AFTER_DRAIN) { E.fused(acc, cur, wr, wc, fr, fq, lds, wid, lane); S.done(cur); }
#undef PG8_SA
#undef PG8_SB
#undef PG8_STAGE
#undef PG8_LDA
#undef PG8_LDB
#undef PG8_MMA
#undef PG8_WAIT_V
#undef PG8_WAIT_L
#undef PG8_BAR
#undef PG8_SCHED
}
}

constexpr int NB = 8, SEQ = 2048, T = NB * SEQ, D = 2048, FF = 5632, NIN = 4352, NMOD = 9 * D;
constexpr float EPS = 1e-5f;
constexpr size_t MiB = 1u << 20;
constexpr size_t WS_WGU1 = 0, WS_WD1 = 44 * MiB, WS_WIN = 66 * MiB, WS_WOUT = 83 * MiB, WS_WGU2 = 91 * MiB, WS_WD2 = 135 * MiB;
constexpr size_t WS_MOD = 157 * MiB, WS_ROPE = 158 * MiB, WS_A = 159 * MiB, WS_R = 223 * MiB;
constexpr size_t WS_U = WS_R;
constexpr size_t WS_PROJ = WS_R, WS_OA = WS_R + 136 * MiB, WS_OB = WS_OA + 32 * MiB, WS_LSE = WS_OB + 96 * MiB, WS_CTL = WS_LSE + 3 * MiB, WS_XB = WS_CTL + 1 * MiB, WS_END = WS_XB + 64 * MiB;
constexpr int LDS_BYTES = 147456, NPH = 13;

#define LAS __attribute__((address_space(3)))
typedef unsigned short bf16;
typedef float f32x4 __attribute__((ext_vector_type(4)));
typedef float f32x16 __attribute__((ext_vector_type(16)));
typedef short bf16x8 __attribute__((ext_vector_type(8)));
typedef short s16x4 __attribute__((ext_vector_type(4)));
typedef unsigned u32x4 __attribute__((ext_vector_type(4)));
typedef unsigned u32x2 __attribute__((ext_vector_type(2)));
using pg8::cvt_pk_bf16;

__device__ __forceinline__ float wave_sum(float v) {
#pragma unroll
    for (int o = 1; o < 64; o <<= 1) v += __shfl_xor(v, o);
    return v;
}
__device__ __forceinline__ float bf_lo(unsigned w) { return __uint_as_float(w << 16); }
__device__ __forceinline__ float bf_hi(unsigned w) { return __uint_as_float(w & 0xffff0000u); }

struct Args { const float* in[20]; float* out; unsigned char* ws; float invf[8]; int ph_lo, ph_hi; };

struct TrItem { const float* W; bf16* WT; int K, N, mode, r; };
__device__ __forceinline__ void tr_load(const TrItem& t, f32x4 (&v)[16], int lane) {
    const int nblk = t.N / 64, kb = t.r / nblk, nb = t.r % nblk, k0 = 64 * kb, n0 = 64 * nb;
#pragma unroll
    for (int i = 0; i < 16; ++i) v[i] = __builtin_nontemporal_load((const f32x4*)(t.W + (size_t)(k0 + 4 * i + (lane >> 4)) * t.N + n0 + (lane & 15) * 4));
}
__device__ __forceinline__ void tr_lds_write(const f32x4 (&v)[16], LAS float* scr, int lane) {
#pragma unroll
    for (int i = 0; i < 16; ++i) { LAS float* s = scr + (4 * i + (lane >> 4)) * 65 + (lane & 15) * 4; s[0] = v[i][0]; s[1] = v[i][1]; s[2] = v[i][2]; s[3] = v[i][3]; }
}
__device__ __forceinline__ void tr_store(const TrItem& t, LAS float* scr, int lane) {
    const int nblk = t.N / 64, kb = t.r / nblk, nb = t.r % nblk, k0 = 64 * kb, n0 = 64 * nb;
    int drow0 = n0;
    if (t.mode == 1) { const int h = n0 >= FF ? 1 : 0, j = n0 - h * FF; drow0 = (j >> 7) * 256 + h * 128 + (j & 127); }
    const int c = lane & 7;
#pragma unroll
    for (int j = 0; j < 8; ++j) {
        const int n = (lane >> 3) + 8 * j; const LAS float* s = scr + (8 * c) * 65 + n;
        u32x4 o; o.x = cvt_pk_bf16(s[0], s[65]); o.y = cvt_pk_bf16(s[2 * 65], s[3 * 65]); o.z = cvt_pk_bf16(s[4 * 65], s[5 * 65]); o.w = cvt_pk_bf16(s[6 * 65], s[7 * 65]);
        *(u32x4*)(t.WT + (size_t)(drow0 + n) * t.K + k0 + 8 * c) = o;
    }
}
__device__ __forceinline__ void transpose_queue(const Args& a, LAS unsigned char* lds, int lane, int wave, int part) {
    unsigned char* ws = a.ws;
    LAS float* scr = (LAS float*)(lds + wave * 16640);
    unsigned* ctr = (unsigned*)(ws + WS_CTL) + 64 * part;
    constexpr int I_GU = (D / 64) * (2 * FF / 64), I_DN = (FF / 64) * (D / 64), I_IN = (D / 64) * (NIN / 64), I_OUT = (D / 64) * (D / 64);
    const int NITEMS = part == 0 ? I_GU + I_DN + I_IN : I_GU + I_DN + I_OUT;
    constexpr int CH = 8;
    static_assert(I_GU % CH == 0 && I_DN % CH == 0 && I_IN % CH == 0 && I_OUT % CH == 0, "chunks");
    auto decode = [&](int r) -> TrItem {
        if (part == 0) {
            if (r < I_GU) return TrItem{a.in[6], (bf16*)(ws + WS_WGU1), D, 2 * FF, 1, r}; r -= I_GU;
            if (r < I_DN) return TrItem{a.in[7], (bf16*)(ws + WS_WD1), FF, D, 0, r}; r -= I_DN;
            return TrItem{a.in[9], (bf16*)(ws + WS_WIN), D, NIN, 0, r};
        }
        if (r < I_GU) return TrItem{a.in[17], (bf16*)(ws + WS_WGU2), D, 2 * FF, 1, r}; r -= I_GU;
        if (r < I_DN) return TrItem{a.in[18], (bf16*)(ws + WS_WD2), FF, D, 0, r}; r -= I_DN;
        return TrItem{a.in[14], (bf16*)(ws + WS_WOUT), D, D, 0, r};
    };
    for (;;) {
        unsigned cidx = 0; if (lane == 0) cidx = atomicAdd(ctr, 1u);
        cidx = __builtin_amdgcn_readfirstlane(cidx);
        if (cidx * CH >= (unsigned)NITEMS) break;
        f32x4 v[16];
        TrItem cur = decode((int)cidx * CH);
        tr_load(cur, v, lane);
#pragma unroll
        for (int q = 0; q < CH; ++q) {
            tr_lds_write(v, scr, lane);
            TrItem nxt = cur;
            if (q + 1 < CH) { nxt = decode((int)cidx * CH + q + 1); tr_load(nxt, v, lane); }
            tr_store(cur, scr, lane);
            cur = nxt;
        }
    }
}

__device__ __forceinline__ void p0_prep(const Args& a, LAS unsigned char* lds, int tid, int lane, int wave, int G, int rep) {
    unsigned char* ws = a.ws;
    if (rep == 0) {
        const int* pos = (const int*)a.in[2]; float* tab = (float*)(ws + WS_ROPE);
        for (int tok = blockIdx.x * 512 + tid; tok < T; tok += G * 512) {
            const float pf = (float)pos[tok];
#pragma unroll
            for (int i = 0; i < 8; ++i) {
                const float ang = pf * a.invf[i];
                double rev = (double)ang * 0.15915494309189535; rev -= floor(rev);
                const float fr = (float)rev;
                tab[tok * 16 + i] = __builtin_amdgcn_cosf(fr); tab[tok * 16 + 8 + i] = __builtin_amdgcn_sinf(fr);
            }
        }
    }
    if (rep == 0) {
        LAS float* scT = (LAS float*)lds;
        LAS float* red = (LAS float*)(lds + 65536);
        const float* cc = a.in[1]; const float* Wa = a.in[3]; const float* ba = a.in[4]; float* mod = (float*)(ws + WS_MOD);
        for (int i = tid; i < NB * D; i += 512) { const int b = i / D, k = i % D; const float x = cc[i]; scT[k * 8 + b] = x / (1.0f + __expf(-x)); }
        __syncthreads();
        for (int it = blockIdx.x; it < NMOD / 64; it += G) {
            const int j = it * 64 + lane; const float* wp = Wa + (size_t)(wave * 256) * NMOD + j;
            float acc[8];
#pragma unroll
            for (int b = 0; b < 8; ++b) acc[b] = 0.f;
            for (int k0 = 0; k0 < 256; k0 += 32) {
                float w[32];
#pragma unroll
                for (int kk = 0; kk < 32; ++kk) w[kk] = __builtin_nontemporal_load(wp + (size_t)(k0 + kk) * NMOD);
#pragma unroll
                for (int kk = 0; kk < 32; ++kk) {
                    const LAS f32x4* sp = (const LAS f32x4*)(scT + (wave * 256 + k0 + kk) * 8);
                    const f32x4 s0 = sp[0], s1 = sp[1];
                    acc[0] += s0[0] * w[kk]; acc[1] += s0[1] * w[kk]; acc[2] += s0[2] * w[kk]; acc[3] += s0[3] * w[kk];
                    acc[4] += s1[0] * w[kk]; acc[5] += s1[1] * w[kk]; acc[6] += s1[2] * w[kk]; acc[7] += s1[3] * w[kk];
                }
            }
#pragma unroll
            for (int b = 0; b < 8; ++b) red[(wave * 8 + b) * 64 + lane] = acc[b];
            __syncthreads();
            { const int b = tid >> 6; float s = 0.f;
#pragma unroll
              for (int w = 0; w < 8; ++w) s += red[(w * 8 + b) * 64 + lane];
              mod[(size_t)b * NMOD + j] = s + ba[j]; }
            __syncthreads();
        }
    }
    __syncthreads();
    __syncthreads();
    transpose_queue(a, lds, lane, wave, 0);
}

template <bool IN_BF16>
__device__ __forceinline__ void norm_phase(const void* Xv, const float* g, const float* mod, int sub, bf16* outb, float* outf, int gw, int NGW, int lane) {
    for (int rb = gw; rb < T / 8; rb += NGW) {
        const int b = rb / (SEQ / 8);
        f32x4 A[8], S[8];
#pragma unroll
        for (int j = 0; j < 8; ++j) {
            const int c4 = (64 * j + lane) * 4;
            A[j] = *(const f32x4*)(g + c4);
            if (mod) { const float* mp = mod + (size_t)b * NMOD + (sub * 3) * D + c4; S[j] = *(const f32x4*)(mp); A[j] = A[j] * (*(const f32x4*)(mp + D) + 1.0f); }
            else S[j] = (f32x4){0.f, 0.f, 0.f, 0.f};
        }
        u32x2 nb[8]; f32x4 nf[8];
#pragma unroll
        for (int j = 0; j < 8; ++j) {
            if (IN_BF16) nb[j] = *(const u32x2*)((const bf16*)Xv + (size_t)rb * 8 * D + (64 * j + lane) * 4);
            else nf[j] = *(const f32x4*)((const float*)Xv + (size_t)rb * 8 * D + (64 * j + lane) * 4);
        }
#pragma unroll 1
        for (int r = 0; r < 8; ++r) {
            const size_t row = (size_t)rb * 8 + r;
            f32x4 v[8]; float ss = 0.f;
#pragma unroll
            for (int j = 0; j < 8; ++j) {
                if (IN_BF16) v[j] = (f32x4){bf_lo(nb[j].x), bf_hi(nb[j].x), bf_lo(nb[j].y), bf_hi(nb[j].y)};
                else v[j] = nf[j];
            }
            if (r + 1 < 8) {
#pragma unroll
                for (int j = 0; j < 8; ++j) {
                    if (IN_BF16) nb[j] = *(const u32x2*)((const bf16*)Xv + (row + 1) * D + (64 * j + lane) * 4);
                    else nf[j] = *(const f32x4*)((const float*)Xv + (row + 1) * D + (64 * j + lane) * 4);
                }
            }
#pragma unroll
            for (int j = 0; j < 8; ++j) ss += (v[j][0] * v[j][0] + v[j][1] * v[j][1]) + (v[j][2] * v[j][2] + v[j][3] * v[j][3]);
            const float rstd = rsqrtf(wave_sum(ss) * (1.0f / D) + EPS);
#pragma unroll
            for (int j = 0; j < 8; ++j) {
                const f32x4 o = v[j] * rstd * A[j] + S[j];
                if (mod) { u32x2 w; w.x = cvt_pk_bf16(o[0], o[1]); w.y = cvt_pk_bf16(o[2], o[3]); *(u32x2*)(outb + row * D + (64 * j + lane) * 4) = w; }
                else *(f32x4*)(outf + row * D + (64 * j + lane) * 4) = o;
            }
        }
    }
}

__device__ __forceinline__ int att_off(int row, int ch) { const int a = (row >> 1) & 7, x = ((a & 1) << 2) | (a >> 1); return row * 128 + ((ch ^ x) << 4); }
__device__ __forceinline__ int crow(int r, int hi) { return (r & 3) + 8 * (r >> 2) + 4 * hi; }

struct AttUnit { int mode, type, head, dil, tok0, q0, qcol, kcol, vcol; };
__device__ __forceinline__ AttUnit att_decode_pair(int u) {
    AttUnit x; x.mode = 0; x.type = u >> 11; const int rem = u & 2047; x.head = rem & 15; const int qg = rem >> 4;
    x.dil = x.type <= 1 ? 1 : (x.type == 2 ? 4 : 16); const int nb = 16 / x.dil, seq = qg / nb, blk = qg % nb, b = seq / x.dil, rr = seq % x.dil;
    x.tok0 = b * SEQ + rr; x.q0 = blk * 128;
    x.qcol = 1280 + x.head * 64; x.kcol = 2304 + x.head * 64; x.vcol = 3328 + x.head * 64;
    return x;
}
__device__ __forceinline__ AttUnit att_decode_gqa(int g, int wave) {
    AttUnit x; x.mode = 1; x.type = 0; const int kvh = g & 1, qb = (g >> 1) & 63, b = g >> 7;
    x.head = 8 * kvh + wave; x.dil = 1; x.tok0 = b * SEQ; x.q0 = qb * 32;
    x.qcol = x.head * 64; x.kcol = 1024 + kvh * 64; x.vcol = 1152 + kvh * 64;
    return x;
}
__device__ __forceinline__ AttUnit att_decode_wide(int w) {
    AttUnit x; x.mode = 2; x.type = 1 + (w >> 10); const int rem = w & 1023; x.head = rem & 15; const int qg = rem >> 4;
    x.dil = x.type == 1 ? 1 : 4; const int nb = 8 / x.dil, seq = qg / nb, blk = qg % nb, b = seq / x.dil, rr = seq % x.dil;
    x.tok0 = b * SEQ + rr; x.q0 = blk * 256;
    x.qcol = 1280 + x.head * 64; x.kcol = 2304 + x.head * 64; x.vcol = 3328 + x.head * 64;
    return x;
}
__device__ __forceinline__ AttUnit att_unit_of(int it, int nG, int nW, int G, int half, int wave) {
    if (it < nG) return att_decode_gqa((int)blockIdx.x + it * G, wave);
    if (it < nG + nW) return att_decode_wide((int)blockIdx.x + (it - nG) * G);
    const int p = (int)blockIdx.x + (it - nG - nW) * G;
    return att_decode_pair(3 * 2048 + 2 * p + half);
}
__device__ __forceinline__ void att_issue(const bf16* P, const AttUnit& x, u32x4 (&kr)[8], u32x4 (&vr)[8], int tid, int htid) {
    const long vdelta = (long)(x.vcol - x.kcol) * 2;
    if (x.mode == 1) {
        const char* sb = (const char*)P + ((long)(x.tok0 + x.q0 - 128) * NIN + x.kcol) * 2;
        const unsigned voff = (unsigned)((tid >> 3) * NIN + (tid & 7) * 8) * 2u;
        const long istride = (long)64 * NIN * 2;
#pragma unroll
        for (int i = 0; i < 3; ++i) {
            if (i < 2 || tid < 256) { kr[i] = *(const u32x4*)(sb + i * istride + voff); vr[i] = *(const u32x4*)(sb + vdelta + i * istride + voff); }
            else { kr[i] = (u32x4){0u, 0u, 0u, 0u}; vr[i] = kr[i]; }
        }
#pragma unroll
        for (int i = 3; i < 8; ++i) { kr[i] = (u32x4){0u, 0u, 0u, 0u}; vr[i] = kr[i]; }
    } else if (x.mode == 2) {
        const char* sb = (const char*)P + ((long)(x.tok0 + (x.q0 - 128) * x.dil) * NIN + x.kcol) * 2;
        const unsigned voff = (unsigned)(((tid >> 3) * x.dil) * NIN + (tid & 7) * 8) * 2u;
        const long istride = (long)64 * x.dil * NIN * 2;
#pragma unroll
        for (int i = 0; i < 6; ++i) { kr[i] = *(const u32x4*)(sb + i * istride + voff); vr[i] = *(const u32x4*)(sb + vdelta + i * istride + voff); }
#pragma unroll
        for (int i = 6; i < 8; ++i) { kr[i] = (u32x4){0u, 0u, 0u, 0u}; vr[i] = kr[i]; }
    } else {
        const char* sb = (const char*)P + ((long)(x.tok0 + (x.q0 - 128) * x.dil) * NIN + x.kcol) * 2;
        const unsigned voff = (unsigned)(((htid >> 3) * x.dil) * NIN + (htid & 7) * 8) * 2u;
        const long istride = (long)32 * x.dil * NIN * 2;
        const bool skip4 = x.q0 == 0;
#pragma unroll
        for (int i = 0; i < 8; ++i) {
            if (i < 4 && skip4) { kr[i] = (u32x4){0u, 0u, 0u, 0u}; vr[i] = kr[i]; }
            else { kr[i] = *(const u32x4*)(sb + i * istride + voff); vr[i] = *(const u32x4*)(sb + vdelta + i * istride + voff); }
        }
    }
}
__device__ __forceinline__ void att_issue_q(const bf16* P, const AttUnit& x, bf16x8 (&qf)[4], int hw, int wave, int r32, int hi) {
    const int hwe = x.mode == 1 ? 0 : (x.mode == 2 ? wave : hw);
    const char* sq = (const char*)P + ((long)(x.tok0 + (x.q0 + 32 * hwe) * x.dil) * NIN + x.qcol) * 2;
    const unsigned qoff = (unsigned)((r32 * x.dil) * NIN + 8 * hi) * 2u;
#pragma unroll
    for (int s = 0; s < 4; ++s) qf[s] = *(const bf16x8*)(sq + 32 * s + qoff);
}

__device__ __forceinline__ void attn_phase(const Args& a, LAS unsigned char* lds, int tid, int lane, int wave, int G) {
    unsigned char* ws = a.ws;
    const bf16* P = (const bf16*)(ws + WS_PROJ);
    const int half = wave >> 2, hw = wave & 3, htid = tid & 255, r32 = lane & 31, hi = lane >> 5;
    LAS unsigned char* Kl = lds + half * 65536; LAS unsigned char* Vl = Kl + 32768;
    const float C2 = 0.125f * 1.4426950408889634f;
    const int blk16 = (lane >> 4) & 1, qq = (lane & 15) >> 2, pp = lane & 3;
    const int bx = (int)blockIdx.x;
    const int nG = bx < 1024 ? (1024 - 1 - bx) / G + 1 : 0, nW = bx < 2048 ? (2048 - 1 - bx) / G + 1 : 0, nP = bx < 1024 ? (1024 - 1 - bx) / G + 1 : 0, niter = nG + nW + nP;
    if (niter == 0) return;
    u32x4 kr[8], vr[8]; bf16x8 qn[4];
    AttUnit cur = att_unit_of(0, nG, nW, G, half, wave);
    att_issue(P, cur, kr, vr, tid, htid); att_issue_q(P, cur, qn, hw, wave, r32, hi);
    for (int it = 0; it < niter; ++it) {
        asm volatile("s_waitcnt lgkmcnt(0)\n\ts_barrier" ::: "memory");
        if (cur.mode == 1) {
#pragma unroll
            for (int i = 0; i < 3; ++i) { const int idx = i * 512 + tid, row = idx >> 3, ch = idx & 7; const int o = att_off(row, ch);
                if (i < 2 || tid < 256) { *(LAS u32x4*)(lds + o) = kr[i]; *(LAS u32x4*)(lds + 32768 + o) = vr[i]; } }
        } else if (cur.mode == 2) {
#pragma unroll
            for (int i = 0; i < 6; ++i) { const int idx = i * 512 + tid, row = idx >> 3, ch = idx & 7; const int o = att_off(row, ch); *(LAS u32x4*)(lds + o) = kr[i]; *(LAS u32x4*)(lds + 49152 + o) = vr[i]; }
        } else {
#pragma unroll
            for (int i = 0; i < 8; ++i) { const int idx = i * 256 + htid, row = idx >> 3, ch = idx & 7; const int o = att_off(row, ch); *(LAS u32x4*)(Kl + o) = kr[i]; *(LAS u32x4*)(Vl + o) = vr[i]; }
        }
        bf16x8 qf[4];
#pragma unroll
        for (int s = 0; s < 4; ++s) qf[s] = qn[s];
        asm volatile("s_waitcnt lgkmcnt(0)\n\ts_barrier" ::: "memory");
        const AttUnit x = cur;
        if (it + 1 < niter) { cur = att_unit_of(it + 1, nG, nW, G, half, wave); att_issue(P, cur, kr, vr, tid, htid); att_issue_q(P, cur, qn, hw, wave, r32, hi); }
        const int hwe = x.mode == 1 ? 0 : (x.mode == 2 ? wave : hw);
        LAS unsigned char* Kb = x.mode == 0 ? Kl : lds; LAS unsigned char* Vb = Kb + (x.mode == 2 ? 49152 : 32768);
        LAS unsigned char* kx[4]; LAS unsigned char* vx[2][2];
#pragma unroll
        for (int s = 0; s < 4; ++s) kx[s] = Kb + att_off(32 * hwe + r32, 2 * s + hi);
#pragma unroll
        for (int t = 0; t < 2; ++t)
#pragma unroll
            for (int c = 0; c < 2; ++c) vx[t][c] = Vb + att_off(32 * hwe + 4 * hi + qq + 8 * t, 4 * c + 2 * blk16 + (pp >> 1)) + 8 * (pp & 1);
        const int ql = 128 + 32 * hwe + r32;
        const int maxd = x.type == 0 ? 127 : 128;
        const float sink2 = x.type == 0 ? a.in[11][x.head] * 1.4426950408889634f : -INFINITY;
        float m = sink2, lsum = 0.f;
        f32x16 o[2]; o[0] = f32x16{}; o[1] = f32x16{};
#pragma unroll
        for (int ti = 4; ti >= 0; --ti) {
            const int tl = hwe + ti; const bool valid = (x.q0 - 128 + 32 * tl) >= 0;
            if (valid) {
                f32x16 acc = {};
#pragma unroll
                for (int s = 0; s < 4; ++s) { const bf16x8 kf = *(const LAS bf16x8*)(kx[s] + ti * 4096); acc = __builtin_amdgcn_mfma_f32_32x32x16_bf16(kf, qf[s], acc, 0, 0, 0); }
                float p[16]; float tmax = -INFINITY;
                if (ti == 4 || ti == 0) {
#pragma unroll
                    for (int r = 0; r < 16; ++r) { const int dd = ql - (32 * tl + crow(r, hi)); const bool ok = dd >= 0 && dd <= maxd; p[r] = ok ? acc[r] * C2 : -INFINITY; tmax = fmaxf(tmax, p[r]); }
                } else {
#pragma unroll
                    for (int r = 0; r < 16; ++r) { p[r] = acc[r] * C2; tmax = fmaxf(tmax, p[r]); }
                }
                tmax = fmaxf(tmax, __shfl_xor(tmax, 32));
                const float mnew = fmaxf(m, tmax);
                if (__any(mnew > m)) {
                    const float alpha = __builtin_amdgcn_exp2f(m - mnew);
                    lsum *= alpha;
#pragma unroll
                    for (int r = 0; r < 16; ++r) { o[0][r] *= alpha; o[1][r] *= alpha; }
                }
                m = mnew;
#pragma unroll
                for (int r = 0; r < 16; ++r) { p[r] = __builtin_amdgcn_exp2f(p[r] - mnew); lsum += p[r]; }
#pragma unroll
                for (int sp = 0; sp < 2; ++sp) {
                    u32x4 pw; pw.x = cvt_pk_bf16(p[8 * sp + 0], p[8 * sp + 1]); pw.y = cvt_pk_bf16(p[8 * sp + 2], p[8 * sp + 3]); pw.z = cvt_pk_bf16(p[8 * sp + 4], p[8 * sp + 5]); pw.w = cvt_pk_bf16(p[8 * sp + 6], p[8 * sp + 7]);
                    const bf16x8 pb = __builtin_bit_cast(bf16x8, pw);
#pragma unroll
                    for (int c = 0; c < 2; ++c) {
                        const s16x4 v0 = __builtin_bit_cast(s16x4, __builtin_amdgcn_ds_read_tr16_b64_v4i16((LAS s16x4*)(vx[0][c] + ti * 4096 + sp * 2048)));
                        const s16x4 v1 = __builtin_bit_cast(s16x4, __builtin_amdgcn_ds_read_tr16_b64_v4i16((LAS s16x4*)(vx[1][c] + ti * 4096 + sp * 2048)));
                        const bf16x8 vf = (bf16x8){v0[0], v0[1], v0[2], v0[3], v1[0], v1[1], v1[2], v1[3]};
                        o[c] = __builtin_amdgcn_mfma_f32_32x32x16_bf16(vf, pb, o[c], 0, 0, 0);
                    }
                }
            }
        }
        lsum += __shfl_xor(lsum, 32);
        if (x.type == 0) lsum += __builtin_amdgcn_exp2f(sink2 - m);
        const float inv = 1.0f / lsum;
        const size_t qtok = (size_t)(x.tok0 + (x.q0 + 32 * hwe + r32) * x.dil);
        bf16* outp = x.type == 0 ? (bf16*)(ws + WS_OA) : (bf16*)(ws + WS_OB) + (size_t)(x.type - 1) * T * 1024;
        bf16* op = outp + qtok * 1024 + x.head * 64 + 4 * hi;
#pragma unroll
        for (int c = 0; c < 2; ++c)
#pragma unroll
            for (int gq = 0; gq < 4; ++gq) { u32x2 w; w.x = cvt_pk_bf16(o[c][4 * gq] * inv, o[c][4 * gq + 1] * inv); w.y = cvt_pk_bf16(o[c][4 * gq + 2] * inv, o[c][4 * gq + 3] * inv); *(u32x2*)(op + 32 * c + 8 * gq) = w; }
        if (x.type != 0 && hi == 0) { float* lsep = (float*)(ws + WS_LSE) + (size_t)(x.type - 1) * T * 16; lsep[qtok * 16 + x.head] = (m + __log2f(lsum)) * 0.6931471805599453f; }
    }
}

__device__ __forceinline__ void combine_phase(const Args& a, int gw, int NGW, int lane) {
    unsigned char* ws = a.ws;
    const bf16* OA = (const bf16*)(ws + WS_OA); const bf16* OB = (const bf16*)(ws + WS_OB); const float* LSE = (const float*)(ws + WS_LSE); bf16* Y = (bf16*)(ws + WS_A);
    const float* ga = a.in[12] + 16 * lane; const float* gb = a.in[13] + 16 * lane;
    float GA[16], GB[16];
#pragma unroll
    for (int i = 0; i < 4; ++i) { const f32x4 x = *(const f32x4*)(ga + 4 * i), y = *(const f32x4*)(gb + 4 * i);
#pragma unroll
        for (int j = 0; j < 4; ++j) { GA[4 * i + j] = x[j]; GB[4 * i + j] = y[j]; } }
    for (int tok = gw; tok < T; tok += NGW) {
        float v[16];
        {
            const u32x4 w0 = *(const u32x4*)(OA + (size_t)tok * 1024 + 16 * lane), w1 = *(const u32x4*)(OA + (size_t)tok * 1024 + 16 * lane + 8);
#pragma unroll
            for (int i = 0; i < 4; ++i) { v[2 * i] = bf_lo(w0[i]); v[2 * i + 1] = bf_hi(w0[i]); v[8 + 2 * i] = bf_lo(w1[i]); v[8 + 2 * i + 1] = bf_hi(w1[i]); }
            float ss = 0.f;
#pragma unroll
            for (int i = 0; i < 16; ++i) ss += v[i] * v[i];
            const float rstd = rsqrtf(wave_sum(ss) * (1.0f / 1024.0f) + EPS);
            u32x4 o0, o1;
#pragma unroll
            for (int i = 0; i < 4; ++i) { o0[i] = cvt_pk_bf16(v[2 * i] * rstd * GA[2 * i], v[2 * i + 1] * rstd * GA[2 * i + 1]); o1[i] = cvt_pk_bf16(v[8 + 2 * i] * rstd * GA[8 + 2 * i], v[9 + 2 * i] * rstd * GA[9 + 2 * i]); }
            *(u32x4*)(Y + (size_t)tok * D + 16 * lane) = o0; *(u32x4*)(Y + (size_t)tok * D + 16 * lane + 8) = o1;
        }
        {
            const int h = lane >> 2;
            const float l0 = LSE[(size_t)tok * 16 + h], l1 = LSE[(size_t)T * 16 + (size_t)tok * 16 + h], l2 = LSE[(size_t)2 * T * 16 + (size_t)tok * 16 + h];
            const float m = fmaxf(l0, fmaxf(l1, l2)); float e0 = __expf(l0 - m), e1 = __expf(l1 - m), e2 = __expf(l2 - m); const float is = 1.0f / (e0 + e1 + e2);
            const float wgt[3] = {e0 * is, e1 * is, e2 * is};
#pragma unroll
            for (int i = 0; i < 16; ++i) v[i] = 0.f;
#pragma unroll
            for (int c = 0; c < 3; ++c) {
                const bf16* src = OB + (size_t)c * T * 1024 + (size_t)tok * 1024 + 16 * lane;
                const u32x4 w0 = *(const u32x4*)(src), w1 = *(const u32x4*)(src + 8);
#pragma unroll
                for (int i = 0; i < 4; ++i) { v[2 * i] += wgt[c] * bf_lo(w0[i]); v[2 * i + 1] += wgt[c] * bf_hi(w0[i]); v[8 + 2 * i] += wgt[c] * bf_lo(w1[i]); v[9 + 2 * i] += wgt[c] * bf_hi(w1[i]); }
            }
            float ss = 0.f;
#pragma unroll
            for (int i = 0; i < 16; ++i) ss += v[i] * v[i];
            const float rstd = rsqrtf(wave_sum(ss) * (1.0f / 1024.0f) + EPS);
            u32x4 o0, o1;
#pragma unroll
            for (int i = 0; i < 4; ++i) { o0[i] = cvt_pk_bf16(v[2 * i] * rstd * GB[2 * i], v[2 * i + 1] * rstd * GB[2 * i + 1]); o1[i] = cvt_pk_bf16(v[8 + 2 * i] * rstd * GB[8 + 2 * i], v[9 + 2 * i] * rstd * GB[9 + 2 * i]); }
            *(u32x4*)(Y + (size_t)tok * D + 1024 + 16 * lane) = o0; *(u32x4*)(Y + (size_t)tok * D + 1024 + 16 * lane + 8) = o1;
        }
    }
}

#define XB_TMO      128
#define XB_XCNT(j)  (256  + 64 * (j))
#define XB_XSUB(j)  (1280 + 64 * (j))
#define XB_XGEN(j)  (2304 + 64 * (j))
#define XB_TOP      3328
#define XB_TOPGEN   3392
#define XCD_BAR_WORDS 3456
#define XB_SPIN_CAP (1u << 24)

__device__ __forceinline__ unsigned xb_ld(unsigned* p)              { return __hip_atomic_load(p, __ATOMIC_RELAXED, __HIP_MEMORY_SCOPE_AGENT); }
__device__ __forceinline__ unsigned xb_add(unsigned* p, unsigned v) { return __hip_atomic_fetch_add(p, v, __ATOMIC_RELAXED, __HIP_MEMORY_SCOPE_AGENT); }
__device__ __forceinline__ unsigned xb_xcc_id() { return (unsigned)__builtin_amdgcn_s_getreg((3 << 11) | 20) & 0xFu; }
#define XB_SPIN(cond, bar) do { unsigned _sp = 0; while (cond) { __builtin_amdgcn_s_sleep(1); \
    if ((++_sp & 255u) == 0u) { if (xb_ld(&(bar)[XB_TMO])) break; if (_sp > XB_SPIN_CAP) { atomicAdd(&(bar)[XB_TMO], 1u); break; } } } } while (0)

struct XcdBarrier {
    unsigned* bar; unsigned x;
    volatile LAS unsigned* st;
};

__device__ __forceinline__ XcdBarrier xcd_barrier_post(unsigned* bar, volatile LAS unsigned* st) {
    XcdBarrier b; b.bar = bar; b.x = xb_xcc_id(); b.st = st;
    if (threadIdx.x == 0) (void)xb_add(&bar[XB_XCNT(b.x)], 1u);
    return b;
}
__device__ __forceinline__ void xcd_barrier_complete(unsigned* bar, unsigned x, unsigned& nloc, unsigned& nx) {
    const unsigned G = gridDim.x * gridDim.y * gridDim.z;
    unsigned sum, cnt, mine, sp = 0u;
    for (;;) {
        sum = 0u; cnt = 0u; mine = 0u;
#pragma unroll
        for (unsigned j = 0; j < 16; ++j) { const unsigned c = xb_ld(&bar[XB_XCNT(j)]); sum += c; cnt += (c > 0u) ? 1u : 0u; mine = (j == x) ? c : mine; }
        if (sum == G) break;
        __builtin_amdgcn_s_sleep(1);
        if ((++sp & 255u) == 0u) { if (xb_ld(&bar[XB_TMO])) break; if (sp > XB_SPIN_CAP) { atomicAdd(&bar[XB_TMO], 1u); break; } }
    }
    nloc = mine > 0u ? mine : 1u; nx = cnt > 0u ? cnt : 1u;
}

__device__ __forceinline__ void xcd_barrier(const XcdBarrier& b) {
    asm volatile("s_waitcnt vmcnt(0)" ::: "memory");
    __syncthreads();
    if (threadIdx.x == 0) {
        unsigned* bar = b.bar;
        __builtin_amdgcn_s_waitcnt(0);
        unsigned nloc = b.st[0], nx = b.st[1];
        if (nloc == 0u) { xcd_barrier_complete(bar, b.x, nloc, nx); b.st[0] = nloc; b.st[1] = nx; }
        const unsigned old = xb_add(&bar[XB_XSUB(b.x)], 1u);
        const unsigned gen = old / nloc;
        if (old + 1u == (gen + 1u) * nloc) {
            __builtin_amdgcn_fence(__ATOMIC_RELEASE, "agent");
            asm volatile("s_waitcnt vmcnt(0)" ::: "memory");
            const unsigned og = xb_add(&bar[XB_TOP], 1u);
            const unsigned tg = og / nx;
            if (og + 1u == (tg + 1u) * nx) xb_add(&bar[XB_TOPGEN], 1u);
            else XB_SPIN(xb_ld(&bar[XB_TOPGEN]) == tg, bar);
            __builtin_amdgcn_fence(__ATOMIC_ACQUIRE, "agent");
            xb_add(&bar[XB_XGEN(b.x)], 1u);
            asm volatile("s_waitcnt vmcnt(0)" ::: "memory");
        } else {
            XB_SPIN(xb_ld(&bar[XB_XGEN(b.x)]) == gen, bar);
            __builtin_amdgcn_fence(__ATOMIC_ACQUIRE, "agent");
            asm volatile("s_waitcnt vmcnt(0)" ::: "memory");
        }
    }
    __syncthreads();
}


__global__ void __launch_bounds__(512, 2) mk_fwd(Args a) {
    extern __shared__ __attribute__((aligned(16))) unsigned char lds_raw[];
    LAS unsigned char* lds = (LAS unsigned char*)lds_raw;
    const int tid = threadIdx.x, lane = tid & 63, wave = __builtin_amdgcn_readfirstlane(tid >> 6);
    const int G = gridDim.x, gw = blockIdx.x * 8 + wave, NGW = G * 8;
    unsigned char* ws = a.ws;
    bf16* Abuf = (bf16*)(ws + WS_A); bf16* U = (bf16*)(ws + WS_U); bf16* XB = (bf16*)(ws + WS_XB); const float* mod = (const float*)(ws + WS_MOD);
#ifndef PHM
#define PHM 0xffff
#endif
#define HAS(k) ((PHM >> (k)) & 1)
    const int lo = a.ph_lo, hi = a.ph_hi;
    volatile LAS unsigned* MISC = (volatile LAS unsigned*)(lds + LDS_BYTES - 256);
    if (tid < 64) MISC[tid] = 0u;
    __syncthreads();
    XcdBarrier xbar; xbar.bar = (unsigned*)(ws + WS_CTL + 16384); xbar.x = 0; xbar.st = nullptr;
    if (hi - lo > 1) xbar = xcd_barrier_post((unsigned*)(ws + WS_CTL + 16384), MISC + 8);
#ifndef REPM
#define REPM 0
#endif
#define REP(k) (((REPM >> (k)) & 1) ? 2 : 1)
#define IN(k) (HAS(k) && lo <= (k) && (k) < hi)
#define SEAM(k) do { if ((k) + 1 < hi && lo <= (k)) { xcd_barrier(xbar); } } while (0)
#define NORM_PH(k, BF, Xp, gp, sub) if (IN(k)) for (int rep_ = 0; rep_ < REP(k); ++rep_) { norm_phase<BF>(Xp, gp, mod, sub, Abuf, nullptr, gw, NGW, lane); } SEAM(k)
#define SWIGLU_PH(k, WOFF) if (IN(k)) for (int rep_ = 0; rep_ < REP(k); ++rep_) { pg8::Gemm g{Abuf, (const bf16*)(ws + (WOFF)), T, 2 * FF, D}; pg8::StaticOrder S; S.init(T, 2 * FF, G, (int)blockIdx.x); \
        pg8::EpiSwiglu E{U, FF}; pg8::gemm_phase<pg8::EpiSwiglu, pg8::StaticOrder, GEMM_ALIGN, GEMM_SP2>(lds, g, S, E); } SEAM(k)
#define RESID_PH(k, BF, Ap, WOFF, KK, basep, biasp, sub, gs) if (IN(k)) for (int rep_ = 0; rep_ < REP(k); ++rep_) { pg8::Gemm g{Ap, (const bf16*)(ws + (WOFF)), T, D, KK}; pg8::StaticOrder S; S.init(T, D, G, (int)blockIdx.x); \
        pg8::EpiResid<BF> E{basep, XB, biasp, mod + ((sub) * 3 + 2) * D, gs, D, NMOD}; pg8::gemm_phase<pg8::EpiResid<BF>, pg8::StaticOrder, GEMM_ALIGN, GEMM_SP2>(lds, g, S, E); } SEAM(k)
    if (hi > 1000) cg::this_grid().sync();
    if (IN(0)) for (int rep_ = 0; rep_ < REP(0); ++rep_) { p0_prep(a, lds, tid, lane, wave, G, rep_); __syncthreads(); }
    SEAM(0);
    NORM_PH(1, false, a.in[0], a.in[5], 0);
    SWIGLU_PH(2, WS_WGU1);
    RESID_PH(3, false, U, WS_WD1, FF, a.in[0], nullptr, 0, 0.5f);
    NORM_PH(4, true, XB, a.in[8], 1);
    if (IN(5)) for (int rep_ = 0; rep_ < REP(5); ++rep_) {
        pg8::Gemm g{Abuf, (const bf16*)(ws + WS_WIN), T, NIN, D}; pg8::StaticOrder S; S.init(T, NIN, G, (int)blockIdx.x);
        pg8::EpiQKV E{(bf16*)(ws + WS_PROJ), a.in[10], (const float*)(ws + WS_ROPE), NIN};
        pg8::gemm_phase<pg8::EpiQKV, pg8::StaticOrder, GEMM_ALIGN, GEMM_SP2>(lds, g, S, E);
        __syncthreads();
        transpose_queue(a, lds, lane, wave, 1);
    }
    SEAM(5);
    if (IN(6)) for (int rep_ = 0; rep_ < REP(6); ++rep_) attn_phase(a, lds, tid, lane, wave, G);
    SEAM(6);
    if (IN(7)) for (int rep_ = 0; rep_ < REP(7); ++rep_) combine_phase(a, gw, NGW, lane);
    SEAM(7);
    RESID_PH(8, true, Abuf, WS_WOUT, D, XB, a.in[15], 1, 1.0f);
    NORM_PH(9, true, XB, a.in[16], 2);
    SWIGLU_PH(10, WS_WGU2);
    RESID_PH(11, true, U, WS_WD2, FF, XB, nullptr, 2, 0.5f);
    if (IN(12)) norm_phase<true>(XB, a.in[19], nullptr, 0, nullptr, a.out, gw, NGW, lane);
}

extern "C" void kernel_launch(void* const* d_in, const int* in_sizes, int n_in, void* d_out, int out_size, void* d_ws, size_t ws_size, hipStream_t stream) {
    static int grid = 0;
    if (grid == 0) {
        if (n_in != 20 || in_sizes[0] != T * D || out_size != T * D || ws_size < WS_END) { fprintf(stderr, "kernel_launch: unexpected shapes / workspace (n_in %d, in0 %d, out %d, ws %zu < %zu)\n", n_in, n_in > 0 ? in_sizes[0] : -1, out_size, ws_size, (size_t)WS_END); grid = -1; return; }
        int dev = 0, cus = 0, per_cu = 0;
        if (hipGetDevice(&dev) != hipSuccess || hipDeviceGetAttribute(&cus, hipDeviceAttributeMultiprocessorCount, dev) != hipSuccess) { grid = -1; return; }
        if (hipFuncSetAttribute((const void*)mk_fwd, hipFuncAttributeMaxDynamicSharedMemorySize, LDS_BYTES) != hipSuccess) { fprintf(stderr, "kernel_launch: hipFuncSetAttribute failed\n"); grid = -1; return; }
        if (hipOccupancyMaxActiveBlocksPerMultiprocessor(&per_cu, (const void*)mk_fwd, 512, LDS_BYTES) != hipSuccess || per_cu < 1) { fprintf(stderr, "kernel_launch: occupancy query says %d\n", per_cu); per_cu = 1; }
        (void)hipGetLastError();
        grid = cus * per_cu;
    }
    if (grid < 0) return;
    (void)hipMemsetAsync((char*)d_ws + WS_CTL, 0, 65536, stream);
    Args a{};
    for (int i = 0; i < 20; ++i) a.in[i] = (const float*)d_in[i];
    a.out = (float*)d_out; a.ws = (unsigned char*)d_ws;
    for (int i = 0; i < 8; ++i) a.invf[i] = powf(500000.0f, -((float)(2 * i) / 16.0f));
#if MK_MULTI
#ifndef DBG_LAST
#define DBG_LAST (NPH - 1)
#endif
    for (int ph = 0; ph <= DBG_LAST; ++ph) {
#ifdef DBG_SKIP
        if ((DBG_SKIP >> ph) & 1) continue;
#endif
        a.ph_lo = ph; a.ph_hi = ph + 1; hipLaunchKernelGGL(mk_fwd, dim3(grid), dim3(512), LDS_BYTES, stream, a); }
#else
    a.ph_lo = 0; a.ph_hi = NPH;
    void* args[] = {&a};
    hipError_t e = hipLaunchCooperativeKernel((const void*)mk_fwd, dim3(grid), dim3(512), args, LDS_BYTES, stream);
    if (e != hipSuccess) fprintf(stderr, "cooperative launch failed: %s (grid %d)\n", hipGetErrorString(e), grid);
#endif
}
```

```cpp
#include <hip/hip_runtime.h>
#include <hip/hip_cooperative_groups.h>
#include <cstdio>
#include <cstdint>
#include <cmath>
namespace cg = cooperative_groups;
#ifndef MK_MULTI
#define MK_MULTI 0
#ifndef GEMM_ALIGN
#define GEMM_ALIGN true
#endif
#ifndef GEMM_SP2
#define GEMM_SP2 true
#endif
#endif
namespace pg8 {
#define PG8_LAS __attribute__((address_space(3)))
typedef unsigned short bf16_t;
typedef short bf16x8 __attribute__((ext_vector_type(8)));
typedef float f32x4 __attribute__((ext_vector_type(4)));
typedef unsigned u32x4 __attribute__((ext_vector_type(4)));
constexpr int BM = 256, BK = 64, HALF = 128, HTB = HALF * BK * 2  , STAGE_BYTES = 8 * HTB, NXCD = 8, WGM = 8;

__host__ __device__ __forceinline__ int lds_byte(int r, int c) { const int st = (r >> 4) * 2 + (c >> 5), rr = r & 15, cc = c & 31, ob = rr * 64 + cc * 2; return st * 1024 + (ob ^ (((ob >> 9) & 1) << 5)); }
__host__ __device__ __forceinline__ void stage_rc(int b, int& R, int& C) { const int st = b / 1024, sb = b % 1024, swz = sb ^ (((sb >> 9) & 1) << 5); R = (st >> 1) * 16 + swz / 64; C = (st & 1) * 32 + (swz % 64) / 2; }
__host__ __device__ __forceinline__ int perm32(int rho) { const int n = rho >> 4, i = rho & 15; return 8 * (i >> 2) + 4 * n + (i & 3); }

struct Unit { int pm, pn; };
struct Gemm { const bf16_t* A; const bf16_t* Bt; int M, N, K; };

struct StaticOrder {
    int nM, nN, nwg, G, c;
    __host__ __device__ void init(int M, int N, int G_, int c_) { nM = M / BM; nN = N / BM; nwg = nM * nN; G = G_; c = c_; }
    __host__ __device__ bool next(int i, Unit& u) const {
        const long L = (long)i * G + c; if (L >= nwg) return false;
        int wgid = (int)L; { const int q = nwg / NXCD, r = nwg % NXCD, xcd = wgid % NXCD, off = wgid / NXCD; wgid = (xcd < r ? xcd * (q + 1) : r * (q + 1) + (xcd - r) * q) + off; }
        const int nig = WGM * nN, gid = wgid / nig, fm = gid * WGM, gsz = (nM - fm) < WGM ? (nM - fm) : WGM;
        u.pm = fm + ((wgid % nig) % gsz); u.pn = (wgid % nig) / gsz; return true;
    }
    __device__ __forceinline__ void a_ready(const Unit&) const {}
    __device__ __forceinline__ void done(const Unit&) const {}
};

typedef float f32x2_t __attribute__((ext_vector_type(2))); typedef __bf16 bf16x2_t __attribute__((ext_vector_type(2)));
__device__ __forceinline__ unsigned cvt_pk_bf16(float lo, float hi) { f32x2_t v = {lo, hi}; bf16x2_t b = __builtin_convertvector(v, bf16x2_t); return __builtin_bit_cast(unsigned, b); }
__device__ __forceinline__ float silu_mul(float g, float u) { return g * u * __builtin_amdgcn_rcpf(1.0f + __builtin_amdgcn_exp2f(-1.4426950408889634f * g)); }

struct EpiSwiglu {
    static constexpr bool PERM = true, AFTER_DRAIN = false;
    bf16_t* O; int ldo;
    __device__ __forceinline__ void operator()(const f32x4 (&acc)[2][2][4][2], const Unit& u, int wr, int wc, int fr, int fq) const {
        const int row0 = u.pm * BM + wr * 64 + fr, col0 = u.pn * HALF + wc * 32 + 8 * fq;
#ifdef PROBE_SWEPI2
      for (int rp_ = 0; rp_ < 2; ++rp_) { asm volatile("" ::: "memory");
#endif
#pragma unroll
        for (int ai = 0; ai < 2; ++ai)
#pragma unroll
            for (int m = 0; m < 4; ++m) {
                bf16_t* p = O + (size_t)(row0 + ai * HALF + m * 16) * ldo + col0;
                const f32x4 g0 = acc[ai][0][m][0], g1 = acc[ai][0][m][1], u0 = acc[ai][1][m][0], u1 = acc[ai][1][m][1];
                u32x4 w;
                w.x = cvt_pk_bf16(silu_mul(g0[0], u0[0]), silu_mul(g0[1], u0[1]));
                w.y = cvt_pk_bf16(silu_mul(g0[2], u0[2]), silu_mul(g0[3], u0[3]));
                w.z = cvt_pk_bf16(silu_mul(g1[0], u1[0]), silu_mul(g1[1], u1[1]));
                w.w = cvt_pk_bf16(silu_mul(g1[2], u1[2]), silu_mul(g1[3], u1[3]));
                *(u32x4*)p = w;
            }
#ifdef PROBE_SWEPI2
      }
#endif
    }
};

template <bool BASE_BF16> struct EpiResid {
    static constexpr bool PERM = true, AFTER_DRAIN = false;
    const void* base; bf16_t* out; const float* bias; const float* gatev; float gs; int ldc, gstride;
    __device__ __forceinline__ void operator()(const f32x4 (&acc)[2][2][4][2], const Unit& u, int wr, int wc, int fr, int fq) const {
        const float* gp = gatev + (size_t)(u.pm >> 3) * gstride;
        const int row0 = u.pm * BM + wr * 64 + fr;
#pragma unroll
        for (int bj = 0; bj < 2; ++bj) {
            const int col0 = u.pn * BM + bj * HALF + wc * 32 + 8 * fq;
            const f32x4 g0 = *(const f32x4*)(gp + col0) * gs, g1 = *(const f32x4*)(gp + col0 + 4) * gs;
            const f32x4 b0 = bias ? *(const f32x4*)(bias + col0) : (f32x4){0.f, 0.f, 0.f, 0.f}, b1 = bias ? *(const f32x4*)(bias + col0 + 4) : (f32x4){0.f, 0.f, 0.f, 0.f};
#pragma unroll
            for (int ai = 0; ai < 2; ++ai)
#pragma unroll
                for (int m = 0; m < 4; ++m) {
                    const size_t off = (size_t)(row0 + ai * HALF + m * 16) * ldc + col0;
                    f32x4 s0, s1;
                    if (BASE_BF16) { const u32x4 w = *(const u32x4*)((const bf16_t*)base + off);
                        s0 = (f32x4){__uint_as_float(w.x << 16), __uint_as_float(w.x & 0xffff0000u), __uint_as_float(w.y << 16), __uint_as_float(w.y & 0xffff0000u)};
                        s1 = (f32x4){__uint_as_float(w.z << 16), __uint_as_float(w.z & 0xffff0000u), __uint_as_float(w.w << 16), __uint_as_float(w.w & 0xffff0000u)}; }
                    else { s0 = *(const f32x4*)((const float*)base + off); s1 = *(const f32x4*)((const float*)base + off + 4); }
                    const f32x4 v0 = s0 + g0 * (acc[ai][bj][m][0] + b0), v1 = s1 + g1 * (acc[ai][bj][m][1] + b1);
                    u32x4 w; w.x = cvt_pk_bf16(v0[0], v0[1]); w.y = cvt_pk_bf16(v0[2], v0[3]); w.z = cvt_pk_bf16(v1[0], v1[1]); w.w = cvt_pk_bf16(v1[2], v1[3]);
                    *(u32x4*)(out + off) = w;
                }
        }
    }
};

struct EpiQKV {
    static constexpr bool PERM = true, AFTER_DRAIN = false;
    bf16_t* O; const float* bias; const float* rope; int ldo;
    __device__ __forceinline__ void operator()(const f32x4 (&acc)[2][2][4][2], const Unit& u, int wr, int wc, int fr, int fq) const {
        const int row0 = u.pm * BM + wr * 64 + fr;
#pragma unroll
        for (int bj = 0; bj < 2; ++bj) {
            const int ch = u.pn * BM + bj * HALF;
            const bool rope_on = ((ch < 1152) || (ch >= 1280 && ch < 3328)) && ((wc & 1) == 0);
            const int col0 = ch + wc * 32 + 8 * fq;
            const f32x4 b0 = *(const f32x4*)(bias + col0), b1 = *(const f32x4*)(bias + col0 + 4);
#pragma unroll
            for (int ai = 0; ai < 2; ++ai)
#pragma unroll
                for (int m = 0; m < 4; ++m) {
                    const int row = row0 + ai * HALF + m * 16;
                    f32x4 x0 = acc[ai][bj][m][0] + b0, x1 = acc[ai][bj][m][1] + b1;
                    if (rope_on) {
                        f32x4 y0, y1;
#pragma unroll
                        for (int i = 0; i < 4; ++i) { y0[i] = __shfl_xor(x0[i], 16); y1[i] = __shfl_xor(x1[i], 16); }
                        if (fq < 2) {
                            const float* rp = rope + (size_t)row * 16;
                            const f32x4 c0 = *(const f32x4*)(rp), c1 = *(const f32x4*)(rp + 4), s0 = *(const f32x4*)(rp + 8), s1 = *(const f32x4*)(rp + 12);
                            if (fq == 0) { x0 = x0 * c0 - y0 * s0; x1 = x1 * c1 - y1 * s1; }
                            else         { x0 = x0 * c0 + y0 * s0; x1 = x1 * c1 + y1 * s1; }
                        }
                    }
                    u32x4 w; w.x = cvt_pk_bf16(x0[0], x0[1]); w.y = cvt_pk_bf16(x0[2], x0[3]); w.z = cvt_pk_bf16(x1[0], x1[1]); w.w = cvt_pk_bf16(x1[2], x1[3]);
                    *(u32x4*)(O + (size_t)row * ldo + col0) = w;
                }
        }
    }
};

template <class Epi, class Sched, bool ALIGN_EPI = false, bool SP2 = false>
__device__ __forceinline__ void gemm_phase(PG8_LAS unsigned char* lds, const Gemm g, const Sched& S, const Epi& E) {
    const int tid = threadIdx.x, wid = __builtin_amdgcn_readfirstlane(tid >> 6), lane = tid & 63, wr = wid >> 2, wc = wid & 3, fr = lane & 15, fq = lane >> 4;
    const int K = g.K, nt = K / BK;
    unsigned voffA[2], voffB[2];
#pragma unroll
    for (int i = 0; i < 2; ++i) { int R, C; stage_rc(tid * 16 + i * 8192, R, C); const int Rb = Epi::PERM ? ((R & ~31) + perm32(R & 31)) : R;
        voffA[i] = (unsigned)(R * K + C) * 2u; voffB[i] = (unsigned)(Rb * K + C) * 2u; }
    const size_t kstep = (size_t)(BK * 2);
    const size_t hstep = (size_t)HALF * K * 2;
    const size_t tstep = 2 * hstep;
    const unsigned ldsw = (unsigned)wid * 1024u;
    const int aoff = lds_byte(wr * 64 + fr, fq * 8), boff = lds_byte(wc * 32 + fr, fq * 8);
#define PG8_SA(b, h) (((b) * 2 + (h)) * HTB)
#define PG8_SB(b, h) ((4 + (b) * 2 + (h)) * HTB)
#define PG8_STAGE(bufoff, gbase, voff) do { _Pragma("unroll") for (int _i = 0; _i < 2; ++_i) \
        __builtin_amdgcn_global_load_lds((const unsigned*)((const char*)(gbase) + (voff)[_i]), (PG8_LAS unsigned*)(lds + (bufoff) + ldsw + _i * 8192), 16, 0, 0); } while (0)
#define PG8_LDA(dst, b, h) do { _Pragma("unroll") for (int m = 0; m < 4; ++m) _Pragma("unroll") for (int k = 0; k < 2; ++k) dst[m][k] = *(const PG8_LAS bf16x8*)(lds + PG8_SA(b, h) + aoff + m * 2048 + k * 1024); } while (0)
#define PG8_LDB(dst, b, h) do { _Pragma("unroll") for (int n = 0; n < 2; ++n) _Pragma("unroll") for (int k = 0; k < 2; ++k) dst[n][k] = *(const PG8_LAS bf16x8*)(lds + PG8_SB(b, h) + boff + n * 2048 + k * 1024); } while (0)
#define PG8_MMA(ai, bj, At, Bt) do { __builtin_amdgcn_s_setprio(1); _Pragma("unroll") for (int m = 0; m < 4; ++m) _Pragma("unroll") for (int n = 0; n < 2; ++n) _Pragma("unroll") for (int k = 0; k < 2; ++k) \
        acc[ai][bj][m][n] = __builtin_amdgcn_mfma_f32_16x16x32_bf16(Bt[n][k], At[m][k], acc[ai][bj][m][n], 0, 0, 0); __builtin_amdgcn_s_setprio(0); } while (0)
#define PG8_WAIT_V(n) asm volatile("s_waitcnt vmcnt(" #n ")" ::: "memory")
#define PG8_WAIT_L(n) asm volatile("s_waitcnt lgkmcnt(" #n ")" ::: "memory")
#define PG8_BAR __builtin_amdgcn_s_barrier()
#define PG8_SCHED __builtin_amdgcn_sched_barrier(0)
    Unit cur, nxt; int ui = 0;
    if (!S.next(0, cur)) return;
    f32x4 acc[2][2][4][2];
#pragma unroll
    for (int a = 0; a < 2; ++a)
#pragma unroll
        for (int b = 0; b < 2; ++b)
#pragma unroll
            for (int m = 0; m < 4; ++m)
#pragma unroll
                for (int n = 0; n < 2; ++n) acc[a][b][m][n] = (f32x4){0.f, 0.f, 0.f, 0.f};
    bf16x8 At[4][2], B0[2][2], B1[2][2];
    const char* cA = (const char*)g.A + (size_t)cur.pm * tstep; const char* cB = (const char*)g.Bt + (size_t)cur.pn * tstep;
    S.a_ready(cur);
    if constexpr (SP2) {
        PG8_STAGE(PG8_SB(0, 0), cB, voffB); PG8_STAGE(PG8_SB(0, 1), cB + hstep, voffB); PG8_STAGE(PG8_SA(0, 0), cA, voffA); PG8_STAGE(PG8_SA(0, 1), cA + hstep, voffA);
        if (wr == 1) PG8_BAR;
        PG8_WAIT_V(2); PG8_BAR;
        PG8_STAGE(PG8_SB(1, 0), cB + kstep, voffB); PG8_STAGE(PG8_SA(1, 0), cA + kstep, voffA); PG8_STAGE(PG8_SB(1, 1), cB + hstep + kstep, voffB);
        PG8_WAIT_V(6); PG8_BAR;
    } else {
        PG8_STAGE(PG8_SB(0, 0), cB, voffB); PG8_STAGE(PG8_SA(0, 0), cA, voffA); PG8_STAGE(PG8_SB(0, 1), cB + hstep, voffB); PG8_STAGE(PG8_SA(0, 1), cA + hstep, voffA);
        if (wr == 1) PG8_BAR;
        PG8_WAIT_V(4); PG8_BAR;
        PG8_STAGE(PG8_SB(1, 0), cB + kstep, voffB); PG8_STAGE(PG8_SA(1, 0), cA + kstep, voffA); PG8_STAGE(PG8_SB(1, 1), cB + hstep + kstep, voffB);
        PG8_WAIT_V(6); PG8_BAR;
    }
    for (;;) {
        const bool has_next = S.next(ui + 1, nxt);
        const char* nA = has_next ? (const char*)g.A + (size_t)nxt.pm * tstep : cA; const char* nB = has_next ? (const char*)g.Bt + (size_t)nxt.pn * tstep : cB;
        for (int t = 0; t < nt; t += 2) {
            const bool last = (t == nt - 2);
            const char* a1 = cA + (size_t)(t + 1) * kstep;
            const char* a2 = last ? nA : cA + (size_t)(t + 2) * kstep; const char* b2 = last ? nB : cB + (size_t)(t + 2) * kstep;
            const char* a3 = a2 + kstep; const char* b3 = b2 + kstep;
            if (last && has_next) S.a_ready(nxt);
            if constexpr (SP2) {
            PG8_LDB(B0, 0, 0); PG8_LDB(B1, 0, 1); PG8_SCHED; PG8_LDA(At, 0, 0); PG8_STAGE(PG8_SA(1, 1), a1 + hstep, voffA);
            PG8_WAIT_V(8); PG8_WAIT_L(0); PG8_BAR; PG8_MMA(0, 0, At, B0); PG8_MMA(0, 1, At, B1); PG8_BAR; PG8_SCHED;
            PG8_LDA(At, 0, 1); PG8_STAGE(PG8_SB(0, 0), b2, voffB); PG8_STAGE(PG8_SB(0, 1), b2 + hstep, voffB); PG8_STAGE(PG8_SA(0, 0), a2, voffA);
            PG8_WAIT_V(8); PG8_WAIT_L(0); PG8_BAR; PG8_MMA(1, 0, At, B0); PG8_MMA(1, 1, At, B1); PG8_BAR; PG8_SCHED;
            PG8_LDB(B0, 1, 0); PG8_LDB(B1, 1, 1); PG8_SCHED; PG8_LDA(At, 1, 0); PG8_STAGE(PG8_SA(0, 1), a2 + hstep, voffA);
            PG8_WAIT_V(8); PG8_WAIT_L(0); PG8_BAR; PG8_MMA(0, 0, At, B0); PG8_MMA(0, 1, At, B1); PG8_BAR; PG8_SCHED;
            PG8_LDA(At, 1, 1); PG8_STAGE(PG8_SB(1, 0), b3, voffB); PG8_STAGE(PG8_SB(1, 1), b3 + hstep, voffB); PG8_STAGE(PG8_SA(1, 0), a3, voffA);
            PG8_WAIT_V(8); PG8_WAIT_L(0); PG8_BAR; PG8_MMA(1, 0, At, B0); PG8_MMA(1, 1, At, B1); PG8_BAR; PG8_SCHED;
            } else {
            PG8_LDB(B0, 0, 0); PG8_SCHED; PG8_LDA(At, 0, 0); PG8_STAGE(PG8_SA(1, 1), a1 + hstep, voffA);
            PG8_WAIT_L(8); PG8_BAR; PG8_WAIT_L(0); PG8_MMA(0, 0, At, B0); PG8_BAR; PG8_SCHED;
            PG8_LDB(B1, 0, 1); PG8_STAGE(PG8_SB(0, 0), b2, voffB);
            PG8_BAR; PG8_WAIT_L(0); PG8_MMA(0, 1, At, B1); PG8_BAR;
            PG8_LDA(At, 0, 1); PG8_STAGE(PG8_SA(0, 0), a2, voffA);
            PG8_BAR; PG8_WAIT_L(0); PG8_MMA(1, 0, At, B0); PG8_BAR; PG8_SCHED;
            PG8_STAGE(PG8_SB(0, 1), b2 + hstep, voffB);
            PG8_WAIT_V(6); PG8_BAR; PG8_MMA(1, 1, At, B1); PG8_BAR;
            PG8_LDB(B0, 1, 0); PG8_SCHED; PG8_LDA(At, 1, 0); PG8_STAGE(PG8_SA(0, 1), a2 + hstep, voffA);
            PG8_WAIT_L(8); PG8_BAR; PG8_WAIT_L(0); PG8_MMA(0, 0, At, B0); PG8_BAR; PG8_SCHED;
            PG8_LDB(B1, 1, 1); PG8_STAGE(PG8_SB(1, 0), b3, voffB);
            PG8_BAR; PG8_WAIT_L(0); PG8_MMA(0, 1, At, B1); PG8_BAR;
            PG8_LDA(At, 1, 1); PG8_STAGE(PG8_SA(1, 0), a3, voffA);
            PG8_BAR; PG8_WAIT_L(0); PG8_MMA(1, 0, At, B0); PG8_BAR; PG8_SCHED;
            PG8_STAGE(PG8_SB(1, 1), b3 + hstep, voffB);
            PG8_WAIT_V(6); PG8_BAR; PG8_MMA(1, 1, At, B1); PG8_BAR;
            }
        }
        if constexpr (ALIGN_EPI) { if (wr == 0) PG8_BAR; }
        if constexpr (!Epi::AFTER_DRAIN) { E(acc, cur, wr, wc, fr, fq); S.done(cur); }
        if (!has_next) break;
#pragma unroll
        for (int a = 0; a < 2; ++a)
#pragma unroll
            for (int b = 0; b < 2; ++b)
#pragma unroll
                for (int m = 0; m < 4; ++m)
#pragma unroll
                    for (int n = 0; n < 2; ++n) acc[a][b][m][n] = (f32x4){0.f, 0.f, 0.f, 0.f};
        cur = nxt; cA = nA; cB = nB; ++ui;
        if constexpr (ALIGN_EPI) { if (wr == 1) PG8_BAR; }
    }
    PG8_WAIT_V(0);
    if constexpr (!ALIGN_EPI) { if (wr == 0) PG8_BAR; }
    PG8_BAR;
    if constexpr (Epi::AFTER_DRAIN) { E.fused(acc, cur, wr, wc, fr, fq, lds, wid, lane); S.done(cur); }
#undef PG8_SA
#undef PG8_SB
#undef PG8_STAGE
#undef PG8_LDA
#undef PG8_LDB
#undef PG8_MMA
#undef PG8_WAIT_V
#undef PG8_WAIT_L
#undef PG8_BAR
#undef PG8_SCHED
}
}

constexpr int NB = 8, SEQ = 2048, T = NB * SEQ, D = 2048, FF = 5632, NIN = 4352, NMOD = 9 * D;
constexpr float EPS = 1e-5f;
constexpr size_t MiB = 1u << 20;
constexpr size_t WS_WGU1 = 0, WS_WD1 = 44 * MiB, WS_WIN = 66 * MiB, WS_WOUT = 83 * MiB, WS_WGU2 = 91 * MiB, WS_WD2 = 135 * MiB;
constexpr size_t WS_MOD = 157 * MiB, WS_ROPE = 158 * MiB, WS_A = 159 * MiB, WS_R = 223 * MiB;
constexpr size_t WS_U = WS_R;
constexpr size_t WS_PROJ = WS_R, WS_OA = WS_R + 136 * MiB, WS_OB = WS_OA + 32 * MiB, WS_LSE = WS_OB + 96 * MiB, WS_CTL = WS_LSE + 3 * MiB, WS_XB = WS_CTL + 1 * MiB, WS_END = WS_XB + 64 * MiB;
constexpr int LDS_BYTES = 147456, NPH = 13;

#define LAS __attribute__((address_space(3)))
typedef unsigned short bf16;
typedef float f32x4 __attribute__((ext_vector_type(4)));
typedef float f32x16 __attribute__((ext_vector_type(16)));
typedef short bf16x8 __attribute__((ext_vector_type(8)));
typedef short s16x4 __attribute__((ext_vector_type(4)));
typedef unsigned u32x4 __attribute__((ext_vector_type(4)));
typedef unsigned u32x2 __attribute__((ext_vector_type(2)));
using pg8::cvt_pk_bf16;

__device__ __forceinline__ float wave_sum(float v) {
#pragma unroll
    for (int o = 1; o < 64; o <<= 1) v += __shfl_xor(v, o);
    return v;
}
__device__ __forceinline__ float bf_lo(unsigned w) { return __uint_as_float(w << 16); }
__device__ __forceinline__ float bf_hi(unsigned w) { return __uint_as_float(w & 0xffff0000u); }

struct Args { const float* in[20]; float* out; unsigned char* ws; float invf[8]; int ph_lo, ph_hi; };

struct TrItem { const float* W; bf16* WT; int K, N, mode, r; };
__device__ __forceinline__ void tr_load(const TrItem& t, f32x4 (&v)[16], int lane) {
    const int nblk = t.N / 64, kb = t.r / nblk, nb = t.r % nblk, k0 = 64 * kb, n0 = 64 * nb;
#pragma unroll
    for (int i = 0; i < 16; ++i) v[i] = __builtin_nontemporal_load((const f32x4*)(t.W + (size_t)(k0 + 4 * i + (lane >> 4)) * t.N + n0 + (lane & 15) * 4));
}
__device__ __forceinline__ void tr_lds_write(const f32x4 (&v)[16], LAS float* scr, int lane) {
#pragma unroll
    for (int i = 0; i < 16; ++i) { LAS float* s = scr + (4 * i + (lane >> 4)) * 65 + (lane & 15) * 4; s[0] = v[i][0]; s[1] = v[i][1]; s[2] = v[i][2]; s[3] = v[i][3]; }
}
__device__ __forceinline__ void tr_store(const TrItem& t, LAS float* scr, int lane) {
    const int nblk = t.N / 64, kb = t.r / nblk, nb = t.r % nblk, k0 = 64 * kb, n0 = 64 * nb;
    int drow0 = n0;
    if (t.mode == 1) { const int h = n0 >= FF ? 1 : 0, j = n0 - h * FF; drow0 = (j >> 7) * 256 + h * 128 + (j & 127); }
    const int c = lane & 7;
#pragma unroll
    for (int j = 0; j < 8; ++j) {
        const int n = (lane >> 3) + 8 * j; const LAS float* s = scr + (8 * c) * 65 + n;
        u32x4 o; o.x = cvt_pk_bf16(s[0], s[65]); o.y = cvt_pk_bf16(s[2 * 65], s[3 * 65]); o.z = cvt_pk_bf16(s[4 * 65], s[5 * 65]); o.w = cvt_pk_bf16(s[6 * 65], s[7 * 65]);
        *(u32x4*)(t.WT + (size_t)(drow0 + n) * t.K + k0 + 8 * c) = o;
    }
}
__device__ __forceinline__ void transpose_queue(const Args& a, LAS unsigned char* lds, int lane, int wave, int part) {
    unsigned char* ws = a.ws;
    LAS float* scr = (LAS float*)(lds + wave * 16640);
    unsigned* ctr = (unsigned*)(ws + WS_CTL) + 64 * part;
    constexpr int I_GU = (D / 64) * (2 * FF / 64), I_DN = (FF / 64) * (D / 64), I_IN = (D / 64) * (NIN / 64), I_OUT = (D / 64) * (D / 64);
    const int NITEMS = part == 0 ? I_GU + I_DN + I_IN + I_OUT : I_GU + I_DN;
    constexpr int CH = 8;
    static_assert(I_GU % CH == 0 && I_DN % CH == 0 && I_IN % CH == 0 && I_OUT % CH == 0, "chunks");
    auto decode = [&](int r) -> TrItem {
        if (part == 0) {
            if (r < I_GU) return TrItem{a.in[6], (bf16*)(ws + WS_WGU1), D, 2 * FF, 1, r}; r -= I_GU;
            if (r < I_DN) return TrItem{a.in[7], (bf16*)(ws + WS_WD1), FF, D, 0, r}; r -= I_DN;
            if (r < I_IN) return TrItem{a.in[9], (bf16*)(ws + WS_WIN), D, NIN, 0, r}; r -= I_IN;
            return TrItem{a.in[14], (bf16*)(ws + WS_WOUT), D, D, 0, r};
        }
        if (r < I_GU) return TrItem{a.in[17], (bf16*)(ws + WS_WGU2), D, 2 * FF, 1, r}; r -= I_GU;
        return TrItem{a.in[18], (bf16*)(ws + WS_WD2), FF, D, 0, r};
    };
    for (;;) {
        unsigned cidx = 0; if (lane == 0) cidx = atomicAdd(ctr, 1u);
        cidx = __builtin_amdgcn_readfirstlane(cidx);
        if (cidx * CH >= (unsigned)NITEMS) break;
        f32x4 v[16];
        TrItem cur = decode((int)cidx * CH);
        tr_load(cur, v, lane);
#pragma unroll
        for (int q = 0; q < CH; ++q) {
            tr_lds_write(v, scr, lane);
            TrItem nxt = cur;
            if (q + 1 < CH) { nxt = decode((int)cidx * CH + q + 1); tr_load(nxt, v, lane); }
            tr_store(cur, scr, lane);
            cur = nxt;
        }
    }
}

__device__ __forceinline__ void p0_prep(const Args& a, LAS unsigned char* lds, int tid, int lane, int wave, int G, int rep) {
    unsigned char* ws = a.ws;
    if (rep == 0) {
        const int* pos = (const int*)a.in[2]; float* tab = (float*)(ws + WS_ROPE);
        for (int tok = blockIdx.x * 512 + tid; tok < T; tok += G * 512) {
            const float pf = (float)pos[tok];
#pragma unroll
            for (int i = 0; i < 8; ++i) {
                const float ang = pf * a.invf[i];
                double rev = (double)ang * 0.15915494309189535; rev -= floor(rev);
                const float fr = (float)rev;
                tab[tok * 16 + i] = __builtin_amdgcn_cosf(fr); tab[tok * 16 + 8 + i] = __builtin_amdgcn_sinf(fr);
            }
        }
    }
    if (rep == 0) {
        LAS float* scT = (LAS float*)lds;
        LAS float* red = (LAS float*)(lds + 65536);
        const float* cc = a.in[1]; const float* Wa = a.in[3]; const float* ba = a.in[4]; float* mod = (float*)(ws + WS_MOD);
        for (int i = tid; i < NB * D; i += 512) { const int b = i / D, k = i % D; const float x = cc[i]; scT[k * 8 + b] = x / (1.0f + __expf(-x)); }
        __syncthreads();
        for (int it = blockIdx.x; it < NMOD / 64; it += G) {
            const int j = it * 64 + lane; const float* wp = Wa + (size_t)(wave * 256) * NMOD + j;
            float acc[8];
#pragma unroll
            for (int b = 0; b < 8; ++b) acc[b] = 0.f;
            for (int k0 = 0; k0 < 256; k0 += 32) {
                float w[32];
#pragma unroll
                for (int kk = 0; kk < 32; ++kk) w[kk] = __builtin_nontemporal_load(wp + (size_t)(k0 + kk) * NMOD);
#pragma unroll
                for (int kk = 0; kk < 32; ++kk) {
                    const LAS f32x4* sp = (const LAS f32x4*)(scT + (wave * 256 + k0 + kk) * 8);
                    const f32x4 s0 = sp[0], s1 = sp[1];
                    acc[0] += s0[0] * w[kk]; acc[1] += s0[1] * w[kk]; acc[2] += s0[2] * w[kk]; acc[3] += s0[3] * w[kk];
                    acc[4] += s1[0] * w[kk]; acc[5] += s1[1] * w[kk]; acc[6] += s1[2] * w[kk]; acc[7] += s1[3] * w[kk];
                }
            }
#pragma unroll
            for (int b = 0; b < 8; ++b) red[(wave * 8 + b) * 64 + lane] = acc[b];
            __syncthreads();
            { const int b = tid >> 6; float s = 0.f;
#pragma unroll
              for (int w = 0; w < 8; ++w) s += red[(w * 8 + b) * 64 + lane];
              mod[(size_t)b * NMOD + j] = s + ba[j]; }
            __syncthreads();
        }
    }
    __syncthreads();
    __syncthreads();
    transpose_queue(a, lds, lane, wave, 0);
}

template <bool IN_BF16>
__device__ __forceinline__ void norm_phase(const void* Xv, const float* g, const float* mod, int sub, bf16* outb, float* outf, int gw, int NGW, int lane) {
    for (int rb = gw; rb < T / 8; rb += NGW) {
        const int b = rb / (SEQ / 8);
        f32x4 A[8], S[8];
#pragma unroll
        for (int j = 0; j < 8; ++j) {
            const int c4 = (64 * j + lane) * 4;
            A[j] = *(const f32x4*)(g + c4);
            if (mod) { const float* mp = mod + (size_t)b * NMOD + (sub * 3) * D + c4; S[j] = *(const f32x4*)(mp); A[j] = A[j] * (*(const f32x4*)(mp + D) + 1.0f); }
            else S[j] = (f32x4){0.f, 0.f, 0.f, 0.f};
        }
        for (int r = 0; r < 8; ++r) {
            const size_t row = (size_t)rb * 8 + r;
            f32x4 v[8]; float ss = 0.f;
#pragma unroll
            for (int j = 0; j < 8; ++j) {
                if (IN_BF16) { const u32x2 w = *(const u32x2*)((const bf16*)Xv + row * D + (64 * j + lane) * 4); v[j] = (f32x4){bf_lo(w.x), bf_hi(w.x), bf_lo(w.y), bf_hi(w.y)}; }
                else v[j] = *(const f32x4*)((const float*)Xv + row * D + (64 * j + lane) * 4);
                ss += (v[j][0] * v[j][0] + v[j][1] * v[j][1]) + (v[j][2] * v[j][2] + v[j][3] * v[j][3]); }
            const float rstd = rsqrtf(wave_sum(ss) * (1.0f / D) + EPS);
#pragma unroll
            for (int j = 0; j < 8; ++j) {
                const f32x4 o = v[j] * rstd * A[j] + S[j];
                if (mod) { u32x2 w; w.x = cvt_pk_bf16(o[0], o[1]); w.y = cvt_pk_bf16(o[2], o[3]); *(u32x2*)(outb + row * D + (64 * j + lane) * 4) = w; }
                else *(f32x4*)(outf + row * D + (64 * j + lane) * 4) = o;
            }
        }
    }
}

__device__ __forceinline__ int att_off(int row, int ch) { const int a = (row >> 1) & 7, x = ((a & 1) << 2) | (a >> 1); return row * 128 + ((ch ^ x) << 4); }
__device__ __forceinline__ int crow(int r, int hi) { return (r & 3) + 8 * (r >> 2) + 4 * hi; }

struct AttUnit { int mode, type, head, dil, tok0, q0, qcol, kcol, vcol; };
__device__ __forceinline__ AttUnit att_decode_pair(int u) {
    AttUnit x; x.mode = 0; x.type = u >> 11; const int rem = u & 2047; x.head = rem & 15; const int qg = rem >> 4;
    x.dil = x.type <= 1 ? 1 : (x.type == 2 ? 4 : 16); const int nb = 16 / x.dil, seq = qg / nb, blk = qg % nb, b = seq / x.dil, rr = seq % x.dil;
    x.tok0 = b * SEQ + rr; x.q0 = blk * 128;
    x.qcol = 1280 + x.head * 64; x.kcol = 2304 + x.head * 64; x.vcol = 3328 + x.head * 64;
    return x;
}
__device__ __forceinline__ AttUnit att_decode_gqa(int g, int wave) {
    AttUnit x; x.mode = 1; x.type = 0; const int kvh = g & 1, qb = (g >> 1) & 63, b = g >> 7;
    x.head = 8 * kvh + wave; x.dil = 1; x.tok0 = b * SEQ; x.q0 = qb * 32;
    x.qcol = x.head * 64; x.kcol = 1024 + kvh * 64; x.vcol = 1152 + kvh * 64;
    return x;
}
__device__ __forceinline__ AttUnit att_decode_wide(int w) {
    AttUnit x; x.mode = 2; x.type = 1 + (w >> 10); const int rem = w & 1023; x.head = rem & 15; const int qg = rem >> 4;
    x.dil = x.type == 1 ? 1 : 4; const int nb = 8 / x.dil, seq = qg / nb, blk = qg % nb, b = seq / x.dil, rr = seq % x.dil;
    x.tok0 = b * SEQ + rr; x.q0 = blk * 256;
    x.qcol = 1280 + x.head * 64; x.kcol = 2304 + x.head * 64; x.vcol = 3328 + x.head * 64;
    return x;
}
__device__ __forceinline__ AttUnit att_unit_of(int it, int nG, int nW, int G, int half, int wave) {
    if (it < nG) return att_decode_gqa((int)blockIdx.x + it * G, wave);
    if (it < nG + nW) return att_decode_wide((int)blockIdx.x + (it - nG) * G);
    const int p = (int)blockIdx.x + (it - nG - nW) * G;
    return att_decode_pair(3 * 2048 + 2 * p + half);
}
__device__ __forceinline__ void att_issue(const bf16* P, const AttUnit& x, u32x4 (&kr)[8], u32x4 (&vr)[8], int tid, int htid) {
    const long vdelta = (long)(x.vcol - x.kcol) * 2;
    if (x.mode == 1) {
        const char* sb = (const char*)P + ((long)(x.tok0 + x.q0 - 128) * NIN + x.kcol) * 2;
        const unsigned voff = (unsigned)((tid >> 3) * NIN + (tid & 7) * 8) * 2u;
        const long istride = (long)64 * NIN * 2;
#pragma unroll
        for (int i = 0; i < 3; ++i) {
            if (i < 2 || tid < 256) { kr[i] = *(const u32x4*)(sb + i * istride + voff); vr[i] = *(const u32x4*)(sb + vdelta + i * istride + voff); }
            else { kr[i] = (u32x4){0u, 0u, 0u, 0u}; vr[i] = kr[i]; }
        }
#pragma unroll
        for (int i = 3; i < 8; ++i) { kr[i] = (u32x4){0u, 0u, 0u, 0u}; vr[i] = kr[i]; }
    } else if (x.mode == 2) {
        const char* sb = (const char*)P + ((long)(x.tok0 + (x.q0 - 128) * x.dil) * NIN + x.kcol) * 2;
        const unsigned voff = (unsigned)(((tid >> 3) * x.dil) * NIN + (tid & 7) * 8) * 2u;
        const long istride = (long)64 * x.dil * NIN * 2;
#pragma unroll
        for (int i = 0; i < 6; ++i) { kr[i] = *(const u32x4*)(sb + i * istride + voff); vr[i] = *(const u32x4*)(sb + vdelta + i * istride + voff); }
#pragma unroll
        for (int i = 6; i < 8; ++i) { kr[i] = (u32x4){0u, 0u, 0u, 0u}; vr[i] = kr[i]; }
    } else {
        const char* sb = (const char*)P + ((long)(x.tok0 + (x.q0 - 128) * x.dil) * NIN + x.kcol) * 2;
        const unsigned voff = (unsigned)(((htid >> 3) * x.dil) * NIN + (htid & 7) * 8) * 2u;
        const long istride = (long)32 * x.dil * NIN * 2;
        const bool skip4 = x.q0 == 0;
#pragma unroll
        for (int i = 0; i < 8; ++i) {
            if (i < 4 && skip4) { kr[i] = (u32x4){0u, 0u, 0u, 0u}; vr[i] = kr[i]; }
            else { kr[i] = *(const u32x4*)(sb + i * istride + voff); vr[i] = *(const u32x4*)(sb + vdelta + i * istride + voff); }
        }
    }
}
__device__ __forceinline__ void att_issue_q(const bf16* P, const AttUnit& x, bf16x8 (&qf)[4], int hw, int wave, int r32, int hi) {
    const int hwe = x.mode == 1 ? 0 : (x.mode == 2 ? wave : hw);
    const char* sq = (const char*)P + ((long)(x.tok0 + (x.q0 + 32 * hwe) * x.dil) * NIN + x.qcol) * 2;
    const unsigned qoff = (unsigned)((r32 * x.dil) * NIN + 8 * hi) * 2u;
#pragma unroll
    for (int s = 0; s < 4; ++s) qf[s] = *(const bf16x8*)(sq + 32 * s + qoff);
}

__device__ __forceinline__ void attn_phase(const Args& a, LAS unsigned char* lds, int tid, int lane, int wave, int G) {
    unsigned char* ws = a.ws;
    const bf16* P = (const bf16*)(ws + WS_PROJ);
    const int half = wave >> 2, hw = wave & 3, htid = tid & 255, r32 = lane & 31, hi = lane >> 5;
    LAS unsigned char* Kl = lds + half * 65536; LAS unsigned char* Vl = Kl + 32768;
    const float C2 = 0.125f * 1.4426950408889634f;
    const int blk16 = (lane >> 4) & 1, qq = (lane & 15) >> 2, pp = lane & 3;
    const int bx = (int)blockIdx.x;
    const int nG = bx < 1024 ? (1024 - 1 - bx) / G + 1 : 0, nW = bx < 2048 ? (2048 - 1 - bx) / G + 1 : 0, nP = bx < 1024 ? (1024 - 1 - bx) / G + 1 : 0, niter = nG + nW + nP;
    if (niter == 0) return;
    u32x4 kr[8], vr[8]; bf16x8 qn[4];
    AttUnit cur = att_unit_of(0, nG, nW, G, half, wave);
    att_issue(P, cur, kr, vr, tid, htid); att_issue_q(P, cur, qn, hw, wave, r32, hi);
    for (int it = 0; it < niter; ++it) {
        asm volatile("s_waitcnt lgkmcnt(0)\n\ts_barrier" ::: "memory");
        if (cur.mode == 1) {
#pragma unroll
            for (int i = 0; i < 3; ++i) { const int idx = i * 512 + tid, row = idx >> 3, ch = idx & 7; const int o = att_off(row, ch);
                if (i < 2 || tid < 256) { *(LAS u32x4*)(lds + o) = kr[i]; *(LAS u32x4*)(lds + 32768 + o) = vr[i]; } }
        } else if (cur.mode == 2) {
#pragma unroll
            for (int i = 0; i < 6; ++i) { const int idx = i * 512 + tid, row = idx >> 3, ch = idx & 7; const int o = att_off(row, ch); *(LAS u32x4*)(lds + o) = kr[i]; *(LAS u32x4*)(lds + 49152 + o) = vr[i]; }
        } else {
#pragma unroll
            for (int i = 0; i < 8; ++i) { const int idx = i * 256 + htid, row = idx >> 3, ch = idx & 7; const int o = att_off(row, ch); *(LAS u32x4*)(Kl + o) = kr[i]; *(LAS u32x4*)(Vl + o) = vr[i]; }
        }
        bf16x8 qf[4];
#pragma unroll
        for (int s = 0; s < 4; ++s) qf[s] = qn[s];
        asm volatile("s_waitcnt lgkmcnt(0)\n\ts_barrier" ::: "memory");
        const AttUnit x = cur;
        if (it + 1 < niter) { cur = att_unit_of(it + 1, nG, nW, G, half, wave); att_issue(P, cur, kr, vr, tid, htid); att_issue_q(P, cur, qn, hw, wave, r32, hi); }
        const int hwe = x.mode == 1 ? 0 : (x.mode == 2 ? wave : hw);
        LAS unsigned char* Kb = x.mode == 0 ? Kl : lds; LAS unsigned char* Vb = Kb + (x.mode == 2 ? 49152 : 32768);
        LAS unsigned char* kx[4]; LAS unsigned char* vx[2][2];
#pragma unroll
        for (int s = 0; s < 4; ++s) kx[s] = Kb + att_off(32 * hwe + r32, 2 * s + hi);
#pragma unroll
        for (int t = 0; t < 2; ++t)
#pragma unroll
            for (int c = 0; c < 2; ++c) vx[t][c] = Vb + att_off(32 * hwe + 4 * hi + qq + 8 * t, 4 * c + 2 * blk16 + (pp >> 1)) + 8 * (pp & 1);
        const int ql = 128 + 32 * hwe + r32;
        const int maxd = x.type == 0 ? 127 : 128;
        const float sink2 = x.type == 0 ? a.in[11][x.head] * 1.4426950408889634f : -INFINITY;
        float m = sink2, lsum = 0.f;
        f32x16 o[2]; o[0] = f32x16{}; o[1] = f32x16{};
#pragma unroll
        for (int ti = 4; ti >= 0; --ti) {
            const int tl = hwe + ti; const bool valid = (x.q0 - 128 + 32 * tl) >= 0;
            if (valid) {
                f32x16 acc = {};
#pragma unroll
                for (int s = 0; s < 4; ++s) { const bf16x8 kf = *(const LAS bf16x8*)(kx[s] + ti * 4096); acc = __builtin_amdgcn_mfma_f32_32x32x16_bf16(kf, qf[s], acc, 0, 0, 0); }
                float p[16]; float tmax = -INFINITY;
                if (ti == 4 || ti == 0) {
#pragma unroll
                    for (int r = 0; r < 16; ++r) { const int dd = ql - (32 * tl + crow(r, hi)); const bool ok = dd >= 0 && dd <= maxd; p[r] = ok ? acc[r] * C2 : -INFINITY; tmax = fmaxf(tmax, p[r]); }
                } else {
#pragma unroll
                    for (int r = 0; r < 16; ++r) { p[r] = acc[r] * C2; tmax = fmaxf(tmax, p[r]); }
                }
                tmax = fmaxf(tmax, __shfl_xor(tmax, 32));
                const float mnew = fmaxf(m, tmax);
                if (__any(mnew > m)) {
                    const float alpha = __builtin_amdgcn_exp2f(m - mnew);
                    lsum *= alpha;
#pragma unroll
                    for (int r = 0; r < 16; ++r) { o[0][r] *= alpha; o[1][r] *= alpha; }
                }
                m = mnew;
#pragma unroll
                for (int r = 0; r < 16; ++r) { p[r] = __builtin_amdgcn_exp2f(p[r] - mnew); lsum += p[r]; }
#pragma unroll
                for (int sp = 0; sp < 2; ++sp) {
                    u32x4 pw; pw.x = cvt_pk_bf16(p[8 * sp + 0], p[8 * sp + 1]); pw.y = cvt_pk_bf16(p[8 * sp + 2], p[8 * sp + 3]); pw.z = cvt_pk_bf16(p[8 * sp + 4], p[8 * sp + 5]); pw.w = cvt_pk_bf16(p[8 * sp + 6], p[8 * sp + 7]);
                    const bf16x8 pb = __builtin_bit_cast(bf16x8, pw);
#pragma unroll
                    for (int c = 0; c < 2; ++c) {
                        const s16x4 v0 = __builtin_bit_cast(s16x4, __builtin_amdgcn_ds_read_tr16_b64_v4i16((LAS s16x4*)(vx[0][c] + ti * 4096 + sp * 2048)));
                        const s16x4 v1 = __builtin_bit_cast(s16x4, __builtin_amdgcn_ds_read_tr16_b64_v4i16((LAS s16x4*)(vx[1][c] + ti * 4096 + sp * 2048)));
                        const bf16x8 vf = (bf16x8){v0[0], v0[1], v0[2], v0[3], v1[0], v1[1], v1[2], v1[3]};
                        o[c] = __builtin_amdgcn_mfma_f32_32x32x16_bf16(vf, pb, o[c], 0, 0, 0);
                    }
                }
            }
        }
        lsum += __shfl_xor(lsum, 32);
        if (x.type == 0) lsum += __builtin_amdgcn_exp2f(sink2 - m);
        const float inv = 1.0f / lsum;
        const size_t qtok = (size_t)(x.tok0 + (x.q0 + 32 * hwe + r32) * x.dil);
        bf16* outp = x.type == 0 ? (bf16*)(ws + WS_OA) : (bf16*)(ws + WS_OB) + (size_t)(x.type - 1) * T * 1024;
        if (x.mode != 0) {
            LAS unsigned char* st = lds + 98304 + wave * 4608;
            LAS unsigned char* sw = st + r32 * 144 + 8 * hi;
#pragma unroll
            for (int c = 0; c < 2; ++c)
#pragma unroll
                for (int gq = 0; gq < 4; ++gq) { u32x2 w; w.x = cvt_pk_bf16(o[c][4 * gq] * inv, o[c][4 * gq + 1] * inv); w.y = cvt_pk_bf16(o[c][4 * gq + 2] * inv, o[c][4 * gq + 3] * inv);
                    *(LAS u32x2*)(sw + (4 * c + gq) * 16) = w; }
            asm volatile("s_waitcnt lgkmcnt(0)" ::: "memory");
            const LAS unsigned char* sr = st + (lane >> 3) * 144 + (lane & 7) * 16;
            char* ob = (char*)outp + ((long)(x.tok0 + (x.q0 + 32 * hwe) * x.dil) * 1024 + x.head * 64) * 2;
            const unsigned lo = (unsigned)((lane >> 3) * x.dil * 2048 + (lane & 7) * 16);
#pragma unroll
            for (int i = 0; i < 4; ++i) { const u32x4 v = *(const LAS u32x4*)(sr + i * 8 * 144); *(u32x4*)(ob + (long)i * 8 * x.dil * 2048 + lo) = v; }
        } else {
        bf16* op = outp + qtok * 1024 + x.head * 64 + 4 * hi;
#pragma unroll
        for (int c = 0; c < 2; ++c)
#pragma unroll
            for (int gq = 0; gq < 4; ++gq) { u32x2 w; w.x = cvt_pk_bf16(o[c][4 * gq] * inv, o[c][4 * gq + 1] * inv); w.y = cvt_pk_bf16(o[c][4 * gq + 2] * inv, o[c][4 * gq + 3] * inv); *(u32x2*)(op + 32 * c + 8 * gq) = w; }
        }
        if (x.type != 0 && hi == 0) { float* lsep = (float*)(ws + WS_LSE) + (size_t)(x.type - 1) * T * 16; lsep[qtok * 16 + x.head] = (m + __log2f(lsum)) * 0.6931471805599453f; }
    }
}

__device__ __forceinline__ void combine_phase(const Args& a, int gw, int NGW, int lane) {
    unsigned char* ws = a.ws;
    const bf16* OA = (const bf16*)(ws + WS_OA); const bf16* OB = (const bf16*)(ws + WS_OB); const float* LSE = (const float*)(ws + WS_LSE); bf16* Y = (bf16*)(ws + WS_A);
    const float* ga = a.in[12] + 16 * lane; const float* gb = a.in[13] + 16 * lane;
    float GA[16], GB[16];
#pragma unroll
    for (int i = 0; i < 4; ++i) { const f32x4 x = *(const f32x4*)(ga + 4 * i), y = *(const f32x4*)(gb + 4 * i);
#pragma unroll
        for (int j = 0; j < 4; ++j) { GA[4 * i + j] = x[j]; GB[4 * i + j] = y[j]; } }
    for (int tok = gw; tok < T; tok += NGW) {
        float v[16];
        {
            const u32x4 w0 = *(const u32x4*)(OA + (size_t)tok * 1024 + 16 * lane), w1 = *(const u32x4*)(OA + (size_t)tok * 1024 + 16 * lane + 8);
#pragma unroll
            for (int i = 0; i < 4; ++i) { v[2 * i] = bf_lo(w0[i]); v[2 * i + 1] = bf_hi(w0[i]); v[8 + 2 * i] = bf_lo(w1[i]); v[8 + 2 * i + 1] = bf_hi(w1[i]); }
            float ss = 0.f;
#pragma unroll
            for (int i = 0; i < 16; ++i) ss += v[i] * v[i];
            const float rstd = rsqrtf(wave_sum(ss) * (1.0f / 1024.0f) + EPS);
            u32x4 o0, o1;
#pragma unroll
            for (int i = 0; i < 4; ++i) { o0[i] = cvt_pk_bf16(v[2 * i] * rstd * GA[2 * i], v[2 * i + 1] * rstd * GA[2 * i + 1]); o1[i] = cvt_pk_bf16(v[8 + 2 * i] * rstd * GA[8 + 2 * i], v[9 + 2 * i] * rstd * GA[9 + 2 * i]); }
            *(u32x4*)(Y + (size_t)tok * D + 16 * lane) = o0; *(u32x4*)(Y + (size_t)tok * D + 16 * lane + 8) = o1;
        }
        {
            const int h = lane >> 2;
            const float l0 = LSE[(size_t)tok * 16 + h], l1 = LSE[(size_t)T * 16 + (size_t)tok * 16 + h], l2 = LSE[(size_t)2 * T * 16 + (size_t)tok * 16 + h];
            const float m = fmaxf(l0, fmaxf(l1, l2)); float e0 = __expf(l0 - m), e1 = __expf(l1 - m), e2 = __expf(l2 - m); const float is = 1.0f / (e0 + e1 + e2);
            const float wgt[3] = {e0 * is, e1 * is, e2 * is};
#pragma unroll
            for (int i = 0; i < 16; ++i) v[i] = 0.f;
#pragma unroll
            for (int c = 0; c < 3; ++c) {
                const bf16* src = OB + (size_t)c * T * 1024 + (size_t)tok * 1024 + 16 * lane;
                const u32x4 w0 = *(const u32x4*)(src), w1 = *(const u32x4*)(src + 8);
#pragma unroll
                for (int i = 0; i < 4; ++i) { v[2 * i] += wgt[c] * bf_lo(w0[i]); v[2 * i + 1] += wgt[c] * bf_hi(w0[i]); v[8 + 2 * i] += wgt[c] * bf_lo(w1[i]); v[9 + 2 * i] += wgt[c] * bf_hi(w1[i]); }
            }
            float ss = 0.f;
#pragma unroll
            for (int i = 0; i < 16; ++i) ss += v[i] * v[i];
            const float rstd = rsqrtf(wave_sum(ss) * (1.0f / 1024.0f) + EPS);
            u32x4 o0, o1;
#pragma unroll
            for (int i = 0; i < 4; ++i) { o0[i] = cvt_pk_bf16(v[2 * i] * rstd * GB[2 * i], v[2 * i + 1] * rstd * GB[2 * i + 1]); o1[i] = cvt_pk_bf16(v[8 + 2 * i] * rstd * GB[8 + 2 * i], v[9 + 2 * i] * rstd * GB[9 + 2 * i]); }
            *(u32x4*)(Y + (size_t)tok * D + 1024 + 16 * lane) = o0; *(u32x4*)(Y + (size_t)tok * D + 1024 + 16 * lane + 8) = o1;
        }
    }
}

#define XB_TMO      128
#define XB_XCNT(j)  (256  + 64 * (j))
#define XB_XSUB(j)  (1280 + 64 * (j))
#define XB_XGEN(j)  (2304 + 64 * (j))
#define XB_TOP      3328
#define XB_TOPGEN   3392
#define XCD_BAR_WORDS 3456
#define XB_SPIN_CAP (1u << 24)

__device__ __forceinline__ unsigned xb_ld(unsigned* p)              { return __hip_atomic_load(p, __ATOMIC_RELAXED, __HIP_MEMORY_SCOPE_AGENT); }
__device__ __forceinline__ unsigned xb_add(unsigned* p, unsigned v) { return __hip_atomic_fetch_add(p, v, __ATOMIC_RELAXED, __HIP_MEMORY_SCOPE_AGENT); }
__device__ __forceinline__ unsigned xb_xcc_id() { return (unsigned)__builtin_amdgcn_s_getreg((3 << 11) | 20) & 0xFu; }
#define XB_SPIN(cond, bar) do { unsigned _sp = 0; while (cond) { __builtin_amdgcn_s_sleep(1); \
    if ((++_sp & 255u) == 0u) { if (xb_ld(&(bar)[XB_TMO])) break; if (_sp > XB_SPIN_CAP) { atomicAdd(&(bar)[XB_TMO], 1u); break; } } } } while (0)

struct XcdBarrier {
    unsigned* bar; unsigned x;
    volatile LAS unsigned* st;
};

__device__ __forceinline__ XcdBarrier xcd_barrier_post(unsigned* bar, volatile LAS unsigned* st) {
    XcdBarrier b; b.bar = bar; b.x = xb_xcc_id(); b.st = st;
    if (threadIdx.x == 0) (void)xb_add(&bar[XB_XCNT(b.x)], 1u);
    return b;
}
__device__ __forceinline__ void xcd_barrier_complete(unsigned* bar, unsigned x, unsigned& nloc, unsigned& nx) {
    const unsigned G = gridDim.x * gridDim.y * gridDim.z;
    unsigned sum, cnt, mine, sp = 0u;
    for (;;) {
        sum = 0u; cnt = 0u; mine = 0u;
#pragma unroll
        for (unsigned j = 0; j < 16; ++j) { const unsigned c = xb_ld(&bar[XB_XCNT(j)]); sum += c; cnt += (c > 0u) ? 1u : 0u; mine = (j == x) ? c : mine; }
        if (sum == G) break;
        __builtin_amdgcn_s_sleep(1);
        if ((++sp & 255u) == 0u) { if (xb_ld(&bar[XB_TMO])) break; if (sp > XB_SPIN_CAP) { atomicAdd(&bar[XB_TMO], 1u); break; } }
    }
    nloc = mine > 0u ? mine : 1u; nx = cnt > 0u ? cnt : 1u;
}

__device__ __forceinline__ void xcd_barrier(const XcdBarrier& b) {
    asm volatile("s_waitcnt vmcnt(0)" ::: "memory");
    __syncthreads();
    if (threadIdx.x == 0) {
        unsigned* bar = b.bar;
        __builtin_amdgcn_s_waitcnt(0);
        unsigned nloc = b.st[0], nx = b.st[1];
        if (nloc == 0u) { xcd_barrier_complete(bar, b.x, nloc, nx); b.st[0] = nloc; b.st[1] = nx; }
        const unsigned old = xb_add(&bar[XB_XSUB(b.x)], 1u);
        const unsigned gen = old / nloc;
        if (old + 1u == (gen + 1u) * nloc) {
            __builtin_amdgcn_fence(__ATOMIC_RELEASE, "agent");
            asm volatile("s_waitcnt vmcnt(0)" ::: "memory");
            const unsigned og = xb_add(&bar[XB_TOP], 1u);
            const unsigned tg = og / nx;
            if (og + 1u == (tg + 1u) * nx) xb_add(&bar[XB_TOPGEN], 1u);
            else XB_SPIN(xb_ld(&bar[XB_TOPGEN]) == tg, bar);
            __builtin_amdgcn_fence(__ATOMIC_ACQUIRE, "agent");
            xb_add(&bar[XB_XGEN(b.x)], 1u);
            asm volatile("s_waitcnt vmcnt(0)" ::: "memory");
        } else {
            XB_SPIN(xb_ld(&bar[XB_XGEN(b.x)]) == gen, bar);
            __builtin_amdgcn_fence(__ATOMIC_ACQUIRE, "agent");
            asm volatile("s_waitcnt vmcnt(0)" ::: "memory");
        }
    }
    __syncthreads();
}


__global__ void __launch_bounds__(512, 2) mk_fwd(Args a) {
    extern __shared__ __attribute__((aligned(16))) unsigned char lds_raw[];
    LAS unsigned char* lds = (LAS unsigned char*)lds_raw;
    const int tid = threadIdx.x, lane = tid & 63, wave = __builtin_amdgcn_readfirstlane(tid >> 6);
    const int G = gridDim.x, gw = blockIdx.x * 8 + wave, NGW = G * 8;
    unsigned char* ws = a.ws;
    bf16* Abuf = (bf16*)(ws + WS_A); bf16* U = (bf16*)(ws + WS_U); bf16* XB = (bf16*)(ws + WS_XB); const float* mod = (const float*)(ws + WS_MOD);
#ifndef PHM
#define PHM 0xffff
#endif
#define HAS(k) ((PHM >> (k)) & 1)
    const int lo = a.ph_lo, hi = a.ph_hi;
    volatile LAS unsigned* MISC = (volatile LAS unsigned*)(lds + LDS_BYTES - 256);
    if (tid < 64) MISC[tid] = 0u;
    __syncthreads();
    XcdBarrier xbar; xbar.bar = (unsigned*)(ws + WS_CTL + 16384); xbar.x = 0; xbar.st = nullptr;
    if (hi - lo > 1) xbar = xcd_barrier_post((unsigned*)(ws + WS_CTL + 16384), MISC + 8);
#ifndef REPM
#define REPM 0
#endif
#define REP(k) (((REPM >> (k)) & 1) ? 2 : 1)
#define IN(k) (HAS(k) && lo <= (k) && (k) < hi)
#define SEAM(k) do { if ((k) + 1 < hi && lo <= (k)) { xcd_barrier(xbar); } } while (0)
#define NORM_PH(k, BF, Xp, gp, sub) if (IN(k)) for (int rep_ = 0; rep_ < REP(k); ++rep_) { norm_phase<BF>(Xp, gp, mod, sub, Abuf, nullptr, gw, NGW, lane); } SEAM(k)
#define SWIGLU_PH(k, WOFF) if (IN(k)) for (int rep_ = 0; rep_ < REP(k); ++rep_) { pg8::Gemm g{Abuf, (const bf16*)(ws + (WOFF)), T, 2 * FF, D}; pg8::StaticOrder S; S.init(T, 2 * FF, G, (int)blockIdx.x); \
        pg8::EpiSwiglu E{U, FF}; pg8::gemm_phase<pg8::EpiSwiglu, pg8::StaticOrder, GEMM_ALIGN, GEMM_SP2>(lds, g, S, E); } SEAM(k)
#define RESID_PH(k, BF, Ap, WOFF, KK, basep, biasp, sub, gs) if (IN(k)) for (int rep_ = 0; rep_ < REP(k); ++rep_) { pg8::Gemm g{Ap, (const bf16*)(ws + (WOFF)), T, D, KK}; pg8::StaticOrder S; S.init(T, D, G, (int)blockIdx.x); \
        pg8::EpiResid<BF> E{basep, XB, biasp, mod + ((sub) * 3 + 2) * D, gs, D, NMOD}; pg8::gemm_phase<pg8::EpiResid<BF>, pg8::StaticOrder, GEMM_ALIGN, GEMM_SP2>(lds, g, S, E); } SEAM(k)
    if (hi > 1000) cg::this_grid().sync();
    if (IN(0)) for (int rep_ = 0; rep_ < REP(0); ++rep_) { p0_prep(a, lds, tid, lane, wave, G, rep_); __syncthreads(); }
    SEAM(0);
    NORM_PH(1, false, a.in[0], a.in[5], 0);
    SWIGLU_PH(2, WS_WGU1);
    RESID_PH(3, false, U, WS_WD1, FF, a.in[0], nullptr, 0, 0.5f);
    NORM_PH(4, true, XB, a.in[8], 1);
    if (IN(5)) for (int rep_ = 0; rep_ < REP(5); ++rep_) {
        pg8::Gemm g{Abuf, (const bf16*)(ws + WS_WIN), T, NIN, D}; pg8::StaticOrder S; S.init(T, NIN, G, (int)blockIdx.x);
        pg8::EpiQKV E{(bf16*)(ws + WS_PROJ), a.in[10], (const float*)(ws + WS_ROPE), NIN};
        pg8::gemm_phase<pg8::EpiQKV, pg8::StaticOrder, GEMM_ALIGN, GEMM_SP2>(lds, g, S, E);
        __syncthreads();
        transpose_queue(a, lds, lane, wave, 1);
    }
    SEAM(5);
    if (IN(6)) for (int rep_ = 0; rep_ < REP(6); ++rep_) attn_phase(a, lds, tid, lane, wave, G);
    SEAM(6);
    if (IN(7)) for (int rep_ = 0; rep_ < REP(7); ++rep_) combine_phase(a, gw, NGW, lane);
    SEAM(7);
    RESID_PH(8, true, Abuf, WS_WOUT, D, XB, a.in[15], 1, 1.0f);
    NORM_PH(9, true, XB, a.in[16], 2);
    SWIGLU_PH(10, WS_WGU2);
    RESID_PH(11, true, U, WS_WD2, FF, XB, nullptr, 2, 0.5f);
    if (IN(12)) norm_phase<true>(XB, a.in[19], nullptr, 0, nullptr, a.out, gw, NGW, lane);
}

extern "C" void kernel_launch(void* const* d_in, const int* in_sizes, int n_in, void* d_out, int out_size, void* d_ws, size_t ws_size, hipStream_t stream) {
    static int grid = 0;
    if (grid == 0) {
        if (n_in != 20 || in_sizes[0] != T * D || out_size != T * D || ws_size < WS_END) { fprintf(stderr, "kernel_launch: unexpected shapes / workspace (n_in %d, in0 %d, out %d, ws %zu < %zu)\n", n_in, n_in > 0 ? in_sizes[0] : -1, out_size, ws_size, (size_t)WS_END); grid = -1; return; }
        int dev = 0, cus = 0, per_cu = 0;
        if (hipGetDevice(&dev) != hipSuccess || hipDeviceGetAttribute(&cus, hipDeviceAttributeMultiprocessorCount, dev) != hipSuccess) { grid = -1; return; }
        if (hipFuncSetAttribute((const void*)mk_fwd, hipFuncAttributeMaxDynamicSharedMemorySize, LDS_BYTES) != hipSuccess) { fprintf(stderr, "kernel_launch: hipFuncSetAttribute failed\n"); grid = -1; return; }
        if (hipOccupancyMaxActiveBlocksPerMultiprocessor(&per_cu, (const void*)mk_fwd, 512, LDS_BYTES) != hipSuccess || per_cu < 1) { fprintf(stderr, "kernel_launch: occupancy query says %d\n", per_cu); per_cu = 1; }
        (void)hipGetLastError();
        grid = cus * per_cu;
    }
    if (grid < 0) return;
    (void)hipMemsetAsync((char*)d_ws + WS_CTL, 0, 65536, stream);
    Args a{};
    for (int i = 0; i < 20; ++i) a.in[i] = (const float*)d_in[i];
    a.out = (float*)d_out; a.ws = (unsigned char*)d_ws;
    for (int i = 0; i < 8; ++i) a.invf[i] = powf(500000.0f, -((float)(2 * i) / 16.0f));
#if MK_MULTI
#ifndef DBG_LAST
#define DBG_LAST (NPH - 1)
#endif
    for (int ph = 0; ph <= DBG_LAST; ++ph) {
#ifdef DBG_SKIP
        if ((DBG_SKIP >> ph) & 1) continue;
#endif
        a.ph_lo = ph; a.ph_hi = ph + 1; hipLaunchKernelGGL(mk_fwd, dim3(grid), dim3(512), LDS_BYTES, stream, a); }
#else
    a.ph_lo = 0; a.ph_hi = NPH;
    void* args[] = {&a};
    hipError_t e = hipLaunchCooperativeKernel((const void*)mk_fwd, dim3(grid), dim3(512), args, LDS_BYTES, stream);
    if (e != hipSuccess) fprintf(stderr, "cooperative launch failed: %s (grid %d)\n", hipGetErrorString(e), grid);
#endif
}
```

```cpp
#include <hip/hip_runtime.h>
#include <hip/hip_cooperative_groups.h>
#include <cstdio>
#include <cstdint>
#include <cmath>
namespace cg = cooperative_groups;
#ifndef MK_MULTI
#define MK_MULTI 0
#ifndef GEMM_ALIGN
#define GEMM_ALIGN true
#endif
#ifndef GEMM_SP2
#define GEMM_SP2 true
#endif
#endif
namespace pg8 {
#define PG8_LAS __attribute__((address_space(3)))
typedef unsigned short bf16_t;
typedef short bf16x8 __attribute__((ext_vector_type(8)));
typedef float f32x4 __attribute__((ext_vector_type(4)));
typedef unsigned u32x4 __attribute__((ext_vector_type(4)));
constexpr int BM = 256, BK = 64, HALF = 128, HTB = HALF * BK * 2  , STAGE_BYTES = 8 * HTB, NXCD = 8, WGM = 8;

__host__ __device__ __forceinline__ int lds_byte(int r, int c) { const int st = (r >> 4) * 2 + (c >> 5), rr = r & 15, cc = c & 31, ob = rr * 64 + cc * 2; return st * 1024 + (ob ^ (((ob >> 9) & 1) << 5)); }
__host__ __device__ __forceinline__ void stage_rc(int b, int& R, int& C) { const int st = b / 1024, sb = b % 1024, swz = sb ^ (((sb >> 9) & 1) << 5); R = (st >> 1) * 16 + swz / 64; C = (st & 1) * 32 + (swz % 64) / 2; }
__host__ __device__ __forceinline__ int perm32(int rho) { const int n = rho >> 4, i = rho & 15; return 8 * (i >> 2) + 4 * n + (i & 3); }

struct Unit { int pm, pn; };
struct Gemm { const bf16_t* A; const bf16_t* Bt; int M, N, K; };

struct StaticOrder {
    int nM, nN, nwg, G, c;
    __host__ __device__ void init(int M, int N, int G_, int c_) { nM = M / BM; nN = N / BM; nwg = nM * nN; G = G_; c = c_; }
    __host__ __device__ bool next(int i, Unit& u) const {
        const long L = (long)i * G + c; if (L >= nwg) return false;
        int wgid = (int)L; { const int q = nwg / NXCD, r = nwg % NXCD, xcd = wgid % NXCD, off = wgid / NXCD; wgid = (xcd < r ? xcd * (q + 1) : r * (q + 1) + (xcd - r) * q) + off; }
        const int nig = WGM * nN, gid = wgid / nig, fm = gid * WGM, gsz = (nM - fm) < WGM ? (nM - fm) : WGM;
        u.pm = fm + ((wgid % nig) % gsz); u.pn = (wgid % nig) / gsz; return true;
    }
    __device__ __forceinline__ void a_ready(const Unit&) const {}
    __device__ __forceinline__ void done(const Unit&) const {}
};

typedef float f32x2_t __attribute__((ext_vector_type(2))); typedef __bf16 bf16x2_t __attribute__((ext_vector_type(2)));
__device__ __forceinline__ unsigned cvt_pk_bf16(float lo, float hi) { f32x2_t v = {lo, hi}; bf16x2_t b = __builtin_convertvector(v, bf16x2_t); return __builtin_bit_cast(unsigned, b); }
__device__ __forceinline__ float silu_mul(float g, float u) { return g * u * __builtin_amdgcn_rcpf(1.0f + __builtin_amdgcn_exp2f(-1.4426950408889634f * g)); }

struct EpiSwiglu {
    static constexpr bool PERM = true, AFTER_DRAIN = false;
    bf16_t* O; int ldo;
    __device__ __forceinline__ void operator()(const f32x4 (&acc)[2][2][4][2], const Unit& u, int wr, int wc, int fr, int fq) const {
        const int row0 = u.pm * BM + wr * 64 + fr, col0 = u.pn * HALF + wc * 32 + 8 * fq;
#ifdef PROBE_SWEPI2
      for (int rp_ = 0; rp_ < 2; ++rp_) { asm volatile("" ::: "memory");
#endif
#pragma unroll
        for (int ai = 0; ai < 2; ++ai)
#pragma unroll
            for (int m = 0; m < 4; ++m) {
                bf16_t* p = O + (size_t)(row0 + ai * HALF + m * 16) * ldo + col0;
                const f32x4 g0 = acc[ai][0][m][0], g1 = acc[ai][0][m][1], u0 = acc[ai][1][m][0], u1 = acc[ai][1][m][1];
                u32x4 w;
                w.x = cvt_pk_bf16(silu_mul(g0[0], u0[0]), silu_mul(g0[1], u0[1]));
                w.y = cvt_pk_bf16(silu_mul(g0[2], u0[2]), silu_mul(g0[3], u0[3]));
                w.z = cvt_pk_bf16(silu_mul(g1[0], u1[0]), silu_mul(g1[1], u1[1]));
                w.w = cvt_pk_bf16(silu_mul(g1[2], u1[2]), silu_mul(g1[3], u1[3]));
                *(u32x4*)p = w;
            }
#ifdef PROBE_SWEPI2
      }
#endif
    }
};

template <bool BASE_BF16> struct EpiResid {
    static constexpr bool PERM = true, AFTER_DRAIN = false;
    const void* base; bf16_t* out; const float* bias; const float* gatev; float gs; int ldc, gstride;
    __device__ __forceinline__ void operator()(const f32x4 (&acc)[2][2][4][2], const Unit& u, int wr, int wc, int fr, int fq) const {
        const float* gp = gatev + (size_t)(u.pm >> 3) * gstride;
        const int row0 = u.pm * BM + wr * 64 + fr;
#pragma unroll
        for (int bj = 0; bj < 2; ++bj) {
            const int col0 = u.pn * BM + bj * HALF + wc * 32 + 8 * fq;
            const f32x4 g0 = *(const f32x4*)(gp + col0) * gs, g1 = *(const f32x4*)(gp + col0 + 4) * gs;
            const f32x4 b0 = bias ? *(const f32x4*)(bias + col0) : (f32x4){0.f, 0.f, 0.f, 0.f}, b1 = bias ? *(const f32x4*)(bias + col0 + 4) : (f32x4){0.f, 0.f, 0.f, 0.f};
#pragma unroll
            for (int ai = 0; ai < 2; ++ai)
#pragma unroll
                for (int m = 0; m < 4; ++m) {
                    const size_t off = (size_t)(row0 + ai * HALF + m * 16) * ldc + col0;
                    f32x4 s0, s1;
                    if (BASE_BF16) { const u32x4 w = *(const u32x4*)((const bf16_t*)base + off);
                        s0 = (f32x4){__uint_as_float(w.x << 16), __uint_as_float(w.x & 0xffff0000u), __uint_as_float(w.y << 16), __uint_as_float(w.y & 0xffff0000u)};
                        s1 = (f32x4){__uint_as_float(w.z << 16), __uint_as_float(w.z & 0xffff0000u), __uint_as_float(w.w << 16), __uint_as_float(w.w & 0xffff0000u)}; }
                    else { s0 = *(const f32x4*)((const float*)base + off); s1 = *(const f32x4*)((const float*)base + off + 4); }
                    const f32x4 v0 = s0 + g0 * (acc[ai][bj][m][0] + b0), v1 = s1 + g1 * (acc[ai][bj][m][1] + b1);
                    u32x4 w; w.x = cvt_pk_bf16(v0[0], v0[1]); w.y = cvt_pk_bf16(v0[2], v0[3]); w.z = cvt_pk_bf16(v1[0], v1[1]); w.w = cvt_pk_bf16(v1[2], v1[3]);
                    *(u32x4*)(out + off) = w;
                }
        }
    }
};

struct EpiQKV {
    static constexpr bool PERM = true, AFTER_DRAIN = false;
    bf16_t* O; const float* bias; const float* rope; int ldo;
    __device__ __forceinline__ void operator()(const f32x4 (&acc)[2][2][4][2], const Unit& u, int wr, int wc, int fr, int fq) const {
        const int row0 = u.pm * BM + wr * 64 + fr;
#pragma unroll
        for (int bj = 0; bj < 2; ++bj) {
            const int ch = u.pn * BM + bj * HALF;
            const bool rope_on = ((ch < 1152) || (ch >= 1280 && ch < 3328)) && ((wc & 1) == 0);
            const int col0 = ch + wc * 32 + 8 * fq;
            const f32x4 b0 = *(const f32x4*)(bias + col0), b1 = *(const f32x4*)(bias + col0 + 4);
#pragma unroll
            for (int ai = 0; ai < 2; ++ai)
#pragma unroll
                for (int m = 0; m < 4; ++m) {
                    const int row = row0 + ai * HALF + m * 16;
                    f32x4 x0 = acc[ai][bj][m][0] + b0, x1 = acc[ai][bj][m][1] + b1;
                    if (rope_on) {
                        f32x4 y0, y1;
#pragma unroll
                        for (int i = 0; i < 4; ++i) { y0[i] = __shfl_xor(x0[i], 16); y1[i] = __shfl_xor(x1[i], 16); }
                        if (fq < 2) {
                            const float* rp = rope + (size_t)row * 16;
                            const f32x4 c0 = *(const f32x4*)(rp), c1 = *(const f32x4*)(rp + 4), s0 = *(const f32x4*)(rp + 8), s1 = *(const f32x4*)(rp + 12);
                            if (fq == 0) { x0 = x0 * c0 - y0 * s0; x1 = x1 * c1 - y1 * s1; }
                            else         { x0 = x0 * c0 + y0 * s0; x1 = x1 * c1 + y1 * s1; }
                        }
                    }
                    u32x4 w; w.x = cvt_pk_bf16(x0[0], x0[1]); w.y = cvt_pk_bf16(x0[2], x0[3]); w.z = cvt_pk_bf16(x1[0], x1[1]); w.w = cvt_pk_bf16(x1[2], x1[3]);
                    *(u32x4*)(O + (size_t)row * ldo + col0) = w;
                }
        }
    }
};

template <class Epi, class Sched, bool ALIGN_EPI = false, bool SP2 = false>
__device__ __forceinline__ void gemm_phase(PG8_LAS unsigned char* lds, const Gemm g, const Sched& S, const Epi& E) {
    const int tid = threadIdx.x, wid = __builtin_amdgcn_readfirstlane(tid >> 6), lane = tid & 63, wr = wid >> 2, wc = wid & 3, fr = lane & 15, fq = lane >> 4;
    const int K = g.K, nt = K / BK;
    unsigned voffA[2], voffB[2];
#pragma unroll
    for (int i = 0; i < 2; ++i) { int R, C; stage_rc(tid * 16 + i * 8192, R, C); const int Rb = Epi::PERM ? ((R & ~31) + perm32(R & 31)) : R;
        voffA[i] = (unsigned)(R * K + C) * 2u; voffB[i] = (unsigned)(Rb * K + C) * 2u; }
    const size_t kstep = (size_t)(BK * 2);
    const size_t hstep = (size_t)HALF * K * 2;
    const size_t tstep = 2 * hstep;
    const unsigned ldsw = (unsigned)wid * 1024u;
    const int aoff = lds_byte(wr * 64 + fr, fq * 8), boff = lds_byte(wc * 32 + fr, fq * 8);
#define PG8_SA(b, h) (((b) * 2 + (h)) * HTB)
#define PG8_SB(b, h) ((4 + (b) * 2 + (h)) * HTB)
#define PG8_STAGE(bufoff, gbase, voff) do { _Pragma("unroll") for (int _i = 0; _i < 2; ++_i) \
        __builtin_amdgcn_global_load_lds((const unsigned*)((const char*)(gbase) + (voff)[_i]), (PG8_LAS unsigned*)(lds + (bufoff) + ldsw + _i * 8192), 16, 0, 0); } while (0)
#define PG8_LDA(dst, b, h) do { _Pragma("unroll") for (int m = 0; m < 4; ++m) _Pragma("unroll") for (int k = 0; k < 2; ++k) dst[m][k] = *(const PG8_LAS bf16x8*)(lds + PG8_SA(b, h) + aoff + m * 2048 + k * 1024); } while (0)
#define PG8_LDB(dst, b, h) do { _Pragma("unroll") for (int n = 0; n < 2; ++n) _Pragma("unroll") for (int k = 0; k < 2; ++k) dst[n][k] = *(const PG8_LAS bf16x8*)(lds + PG8_SB(b, h) + boff + n * 2048 + k * 1024); } while (0)
#define PG8_MMA(ai, bj, At, Bt) do { __builtin_amdgcn_s_setprio(1); _Pragma("unroll") for (int m = 0; m < 4; ++m) _Pragma("unroll") for (int n = 0; n < 2; ++n) _Pragma("unroll") for (int k = 0; k < 2; ++k) \
        acc[ai][bj][m][n] = __builtin_amdgcn_mfma_f32_16x16x32_bf16(Bt[n][k], At[m][k], acc[ai][bj][m][n], 0, 0, 0); __builtin_amdgcn_s_setprio(0); } while (0)
#define PG8_WAIT_V(n) asm volatile("s_waitcnt vmcnt(" #n ")" ::: "memory")
#define PG8_WAIT_L(n) asm volatile("s_waitcnt lgkmcnt(" #n ")" ::: "memory")
#define PG8_BAR __builtin_amdgcn_s_barrier()
#define PG8_SCHED __builtin_amdgcn_sched_barrier(0)
    Unit cur, nxt; int ui = 0;
    if (!S.next(0, cur)) return;
    f32x4 acc[2][2][4][2];
#pragma unroll
    for (int a = 0; a < 2; ++a)
#pragma unroll
        for (int b = 0; b < 2; ++b)
#pragma unroll
            for (int m = 0; m < 4; ++m)
#pragma unroll
                for (int n = 0; n < 2; ++n) acc[a][b][m][n] = (f32x4){0.f, 0.f, 0.f, 0.f};
    bf16x8 At[4][2], B0[2][2], B1[2][2];
    const char* cA = (const char*)g.A + (size_t)cur.pm * tstep; const char* cB = (const char*)g.Bt + (size_t)cur.pn * tstep;
    S.a_ready(cur);
    if constexpr (SP2) {
        PG8_STAGE(PG8_SB(0, 0), cB, voffB); PG8_STAGE(PG8_SB(0, 1), cB + hstep, voffB); PG8_STAGE(PG8_SA(0, 0), cA, voffA); PG8_STAGE(PG8_SA(0, 1), cA + hstep, voffA);
        if (wr == 1) PG8_BAR;
        PG8_WAIT_V(2); PG8_BAR;
        PG8_STAGE(PG8_SB(1, 0), cB + kstep, voffB); PG8_STAGE(PG8_SA(1, 0), cA + kstep, voffA); PG8_STAGE(PG8_SB(1, 1), cB + hstep + kstep, voffB);
        PG8_WAIT_V(6); PG8_BAR;
    } else {
        PG8_STAGE(PG8_SB(0, 0), cB, voffB); PG8_STAGE(PG8_SA(0, 0), cA, voffA); PG8_STAGE(PG8_SB(0, 1), cB + hstep, voffB); PG8_STAGE(PG8_SA(0, 1), cA + hstep, voffA);
        if (wr == 1) PG8_BAR;
        PG8_WAIT_V(4); PG8_BAR;
        PG8_STAGE(PG8_SB(1, 0), cB + kstep, voffB); PG8_STAGE(PG8_SA(1, 0), cA + kstep, voffA); PG8_STAGE(PG8_SB(1, 1), cB + hstep + kstep, voffB);
        PG8_WAIT_V(6); PG8_BAR;
    }
    for (;;) {
        const bool has_next = S.next(ui + 1, nxt);
        const char* nA = has_next ? (const char*)g.A + (size_t)nxt.pm * tstep : cA; const char* nB = has_next ? (const char*)g.Bt + (size_t)nxt.pn * tstep : cB;
        for (int t = 0; t < nt; t += 2) {
            const bool last = (t == nt - 2);
            const char* a1 = cA + (size_t)(t + 1) * kstep;
            const char* a2 = last ? nA : cA + (size_t)(t + 2) * kstep; const char* b2 = last ? nB : cB + (size_t)(t + 2) * kstep;
            const char* a3 = a2 + kstep; const char* b3 = b2 + kstep;
            if (last && has_next) S.a_ready(nxt);
            if constexpr (SP2) {
            PG8_LDB(B0, 0, 0); PG8_LDB(B1, 0, 1); PG8_SCHED; PG8_LDA(At, 0, 0); PG8_STAGE(PG8_SA(1, 1), a1 + hstep, voffA);
            PG8_WAIT_V(8); PG8_WAIT_L(0); PG8_BAR; PG8_MMA(0, 0, At, B0); PG8_MMA(0, 1, At, B1); PG8_BAR; PG8_SCHED;
            PG8_LDA(At, 0, 1); PG8_STAGE(PG8_SB(0, 0), b2, voffB); PG8_STAGE(PG8_SB(0, 1), b2 + hstep, voffB); PG8_STAGE(PG8_SA(0, 0), a2, voffA);
            PG8_WAIT_V(8); PG8_WAIT_L(0); PG8_BAR; PG8_MMA(1, 0, At, B0); PG8_MMA(1, 1, At, B1); PG8_BAR; PG8_SCHED;
            PG8_LDB(B0, 1, 0); PG8_LDB(B1, 1, 1); PG8_SCHED; PG8_LDA(At, 1, 0); PG8_STAGE(PG8_SA(0, 1), a2 + hstep, voffA);
            PG8_WAIT_V(8); PG8_WAIT_L(0); PG8_BAR; PG8_MMA(0, 0, At, B0); PG8_MMA(0, 1, At, B1); PG8_BAR; PG8_SCHED;
            PG8_LDA(At, 1, 1); PG8_STAGE(PG8_SB(1, 0), b3, voffB); PG8_STAGE(PG8_SB(1, 1), b3 + hstep, voffB); PG8_STAGE(PG8_SA(1, 0), a3, voffA);
            PG8_WAIT_V(8); PG8_WAIT_L(0); PG8_BAR; PG8_MMA(1, 0, At, B0); PG8_MMA(1, 1, At, B1); PG8_BAR; PG8_SCHED;
            } else {
            PG8_LDB(B0, 0, 0); PG8_SCHED; PG8_LDA(At, 0, 0); PG8_STAGE(PG8_SA(1, 1), a1 + hstep, voffA);
            PG8_WAIT_L(8); PG8_BAR; PG8_WAIT_L(0); PG8_MMA(0, 0, At, B0); PG8_BAR; PG8_SCHED;
            PG8_LDB(B1, 0, 1); PG8_STAGE(PG8_SB(0, 0), b2, voffB);
            PG8_BAR; PG8_WAIT_L(0); PG8_MMA(0, 1, At, B1); PG8_BAR;
            PG8_LDA(At, 0, 1); PG8_STAGE(PG8_SA(0, 0), a2, voffA);
            PG8_BAR; PG8_WAIT_L(0); PG8_MMA(1, 0, At, B0); PG8_BAR; PG8_SCHED;
            PG8_STAGE(PG8_SB(0, 1), b2 + hstep, voffB);
            PG8_WAIT_V(6); PG8_BAR; PG8_MMA(1, 1, At, B1); PG8_BAR;
            PG8_LDB(B0, 1, 0); PG8_SCHED; PG8_LDA(At, 1, 0); PG8_STAGE(PG8_SA(0, 1), a2 + hstep, voffA);
            PG8_WAIT_L(8); PG8_BAR; PG8_WAIT_L(0); PG8_MMA(0, 0, At, B0); PG8_BAR; PG8_SCHED;
            PG8_LDB(B1, 1, 1); PG8_STAGE(PG8_SB(1, 0), b3, voffB);
            PG8_BAR; PG8_WAIT_L(0); PG8_MMA(0, 1, At, B1); PG8_BAR;
            PG8_LDA(At, 1, 1); PG8_STAGE(PG8_SA(1, 0), a3, voffA);
            PG8_BAR; PG8_WAIT_L(0); PG8_MMA(1, 0, At, B0); PG8_BAR; PG8_SCHED;
            PG8_STAGE(PG8_SB(1, 1), b3 + hstep, voffB);
            PG8_WAIT_V(6); PG8_BAR; PG8_MMA(1, 1, At, B1); PG8_BAR;
            }
        }
        if constexpr (ALIGN_EPI) { if (wr == 0) PG8_BAR; }
        if constexpr (!Epi::AFTER_DRAIN) { E(acc, cur, wr, wc, fr, fq); S.done(cur); }
        if (!has_next) break;
#pragma unroll
        for (int a = 0; a < 2; ++a)
#pragma unroll
            for (int b = 0; b < 2; ++b)
#pragma unroll
                for (int m = 0; m < 4; ++m)
#pragma unroll
                    for (int n = 0; n < 2; ++n) acc[a][b][m][n] = (f32x4){0.f, 0.f, 0.f, 0.f};
        cur = nxt; cA = nA; cB = nB; ++ui;
        if constexpr (ALIGN_EPI) { if (wr == 1) PG8_BAR; }
    }
    PG8_WAIT_V(0);
    if constexpr (!ALIGN_EPI) { if (wr == 0) PG8_BAR; }
    PG8_BAR;
    if constexpr (Epi::AFTER_DRAIN) { E.fused(acc, cur, wr, wc, fr, fq, lds, wid, lane); S.done(cur); }
#undef PG8_SA
#undef PG8_SB
#undef PG8_STAGE
#undef PG8_LDA
#undef PG8_LDB
#undef PG8_MMA
#undef PG8_WAIT_V
#undef PG8_WAIT_L
#undef PG8_BAR
#undef PG8_SCHED
}
}

constexpr int NB = 8, SEQ = 2048, T = NB * SEQ, D = 2048, FF = 5632, NIN = 4352, NMOD = 9 * D;
constexpr float EPS = 1e-5f;
constexpr size_t MiB = 1u << 20;
constexpr size_t WS_WGU1 = 0, WS_WD1 = 44 * MiB, WS_WIN = 66 * MiB, WS_WOUT = 83 * MiB, WS_WGU2 = 91 * MiB, WS_WD2 = 135 * MiB;
constexpr size_t WS_MOD = 157 * MiB, WS_ROPE = 158 * MiB, WS_A = 159 * MiB, WS_R = 223 * MiB;
constexpr size_t WS_U = WS_R;
constexpr size_t WS_PROJ = WS_R, WS_OA = WS_R + 136 * MiB, WS_OB = WS_OA + 32 * MiB, WS_LSE = WS_OB + 96 * MiB, WS_CTL = WS_LSE + 3 * MiB, WS_XB = WS_CTL + 1 * MiB, WS_END = WS_XB + 64 * MiB;
constexpr int LDS_BYTES = 147456, NPH = 13;

#define LAS __attribute__((address_space(3)))
typedef unsigned short bf16;
typedef float f32x4 __attribute__((ext_vector_type(4)));
typedef float f32x16 __attribute__((ext_vector_type(16)));
typedef short bf16x8 __attribute__((ext_vector_type(8)));
typedef short s16x4 __attribute__((ext_vector_type(4)));
typedef unsigned u32x4 __attribute__((ext_vector_type(4)));
typedef unsigned u32x2 __attribute__((ext_vector_type(2)));
using pg8::cvt_pk_bf16;

__device__ __forceinline__ float wave_sum(float v) {
#pragma unroll
    for (int o = 1; o < 64; o <<= 1) v += __shfl_xor(v, o);
    return v;
}
__device__ __forceinline__ float bf_lo(unsigned w) { return __uint_as_float(w << 16); }
__device__ __forceinline__ float bf_hi(unsigned w) { return __uint_as_float(w & 0xffff0000u); }

struct Args { const float* in[20]; float* out; unsigned char* ws; float invf[8]; int ph_lo, ph_hi; };

struct TrItem { const float* W; bf16* WT; int K, N, mode, r; };
__device__ __forceinline__ void tr_load(const TrItem& t, f32x4 (&v)[16], int lane) {
    const int nblk = t.N / 64, kb = t.r / nblk, nb = t.r % nblk, k0 = 64 * kb, n0 = 64 * nb;
#pragma unroll
    for (int i = 0; i < 16; ++i) v[i] = __builtin_nontemporal_load((const f32x4*)(t.W + (size_t)(k0 + 4 * i + (lane >> 4)) * t.N + n0 + (lane & 15) * 4));
}
__device__ __forceinline__ void tr_lds_write(const f32x4 (&v)[16], LAS float* scr, int lane) {
#pragma unroll
    for (int i = 0; i < 16; ++i) { LAS float* s = scr + (4 * i + (lane >> 4)) * 65 + (lane & 15) * 4; s[0] = v[i][0]; s[1] = v[i][1]; s[2] = v[i][2]; s[3] = v[i][3]; }
}
__device__ __forceinline__ void tr_store(const TrItem& t, LAS float* scr, int lane) {
    const int nblk = t.N / 64, kb = t.r / nblk, nb = t.r % nblk, k0 = 64 * kb, n0 = 64 * nb;
    int drow0 = n0;
    if (t.mode == 1) { const int h = n0 >= FF ? 1 : 0, j = n0 - h * FF; drow0 = (j >> 7) * 256 + h * 128 + (j & 127); }
    const int c = lane & 7;
#pragma unroll
    for (int j = 0; j < 8; ++j) {
        const int n = (lane >> 3) + 8 * j; const LAS float* s = scr + (8 * c) * 65 + n;
        u32x4 o; o.x = cvt_pk_bf16(s[0], s[65]); o.y = cvt_pk_bf16(s[2 * 65], s[3 * 65]); o.z = cvt_pk_bf16(s[4 * 65], s[5 * 65]); o.w = cvt_pk_bf16(s[6 * 65], s[7 * 65]);
        *(u32x4*)(t.WT + (size_t)(drow0 + n) * t.K + k0 + 8 * c) = o;
    }
}
__device__ __forceinline__ void transpose_queue(const Args& a, LAS unsigned char* lds, int lane, int wave, int part) {
    unsigned char* ws = a.ws;
    LAS float* scr = (LAS float*)(lds + wave * 16640);
    unsigned* ctr = (unsigned*)(ws + WS_CTL) + 64 * part;
    constexpr int I_GU = (D / 64) * (2 * FF / 64), I_DN = (FF / 64) * (D / 64), I_IN = (D / 64) * (NIN / 64), I_OUT = (D / 64) * (D / 64);
    const int NITEMS = part == 0 ? I_GU + I_DN + I_IN + I_OUT : I_GU + I_DN;
    constexpr int CH = 8;
    static_assert(I_GU % CH == 0 && I_DN % CH == 0 && I_IN % CH == 0 && I_OUT % CH == 0, "chunks");
    auto decode = [&](int r) -> TrItem {
        if (part == 0) {
            if (r < I_GU) return TrItem{a.in[6], (bf16*)(ws + WS_WGU1), D, 2 * FF, 1, r}; r -= I_GU;
            if (r < I_DN) return TrItem{a.in[7], (bf16*)(ws + WS_WD1), FF, D, 0, r}; r -= I_DN;
            if (r < I_IN) return TrItem{a.in[9], (bf16*)(ws + WS_WIN), D, NIN, 0, r}; r -= I_IN;
            return TrItem{a.in[14], (bf16*)(ws + WS_WOUT), D, D, 0, r};
        }
        if (r < I_GU) return TrItem{a.in[17], (bf16*)(ws + WS_WGU2), D, 2 * FF, 1, r}; r -= I_GU;
        return TrItem{a.in[18], (bf16*)(ws + WS_WD2), FF, D, 0, r};
    };
    for (;;) {
        unsigned cidx = 0; if (lane == 0) cidx = atomicAdd(ctr, 1u);
        cidx = __builtin_amdgcn_readfirstlane(cidx);
        if (cidx * CH >= (unsigned)NITEMS) break;
        f32x4 v[16];
        TrItem cur = decode((int)cidx * CH);
        tr_load(cur, v, lane);
#pragma unroll
        for (int q = 0; q < CH; ++q) {
            tr_lds_write(v, scr, lane);
            TrItem nxt = cur;
            if (q + 1 < CH) { nxt = decode((int)cidx * CH + q + 1); tr_load(nxt, v, lane); }
            tr_store(cur, scr, lane);
            cur = nxt;
        }
    }
}

__device__ __forceinline__ void p0_prep(const Args& a, LAS unsigned char* lds, int tid, int lane, int wave, int G, int rep) {
    unsigned char* ws = a.ws;
    if (rep == 0) {
        const int* pos = (const int*)a.in[2]; float* tab = (float*)(ws + WS_ROPE);
        for (int tok = blockIdx.x * 512 + tid; tok < T; tok += G * 512) {
            const float pf = (float)pos[tok];
#pragma unroll
            for (int i = 0; i < 8; ++i) {
                const float ang = pf * a.invf[i];
                double rev = (double)ang * 0.15915494309189535; rev -= floor(rev);
                const float fr = (float)rev;
                tab[tok * 16 + i] = __builtin_amdgcn_cosf(fr); tab[tok * 16 + 8 + i] = __builtin_amdgcn_sinf(fr);
            }
        }
    }
    if (rep == 0) {
        LAS float* scT = (LAS float*)lds;
        LAS float* red = (LAS float*)(lds + 65536);
        const float* cc = a.in[1]; const float* Wa = a.in[3]; const float* ba = a.in[4]; float* mod = (float*)(ws + WS_MOD);
        for (int i = tid; i < NB * D; i += 512) { const int b = i / D, k = i % D; const float x = cc[i]; scT[k * 8 + b] = x / (1.0f + __expf(-x)); }
        __syncthreads();
        for (int it = blockIdx.x; it < NMOD / 64; it += G) {
            const int j = it * 64 + lane; const float* wp = Wa + (size_t)(wave * 256) * NMOD + j;
            float acc[8];
#pragma unroll
            for (int b = 0; b < 8; ++b) acc[b] = 0.f;
            for (int k0 = 0; k0 < 256; k0 += 32) {
                float w[32];
#pragma unroll
                for (int kk = 0; kk < 32; ++kk) w[kk] = __builtin_nontemporal_load(wp + (size_t)(k0 + kk) * NMOD);
#pragma unroll
                for (int kk = 0; kk < 32; ++kk) {
                    const LAS f32x4* sp = (const LAS f32x4*)(scT + (wave * 256 + k0 + kk) * 8);
                    const f32x4 s0 = sp[0], s1 = sp[1];
                    acc[0] += s0[0] * w[kk]; acc[1] += s0[1] * w[kk]; acc[2] += s0[2] * w[kk]; acc[3] += s0[3] * w[kk];
                    acc[4] += s1[0] * w[kk]; acc[5] += s1[1] * w[kk]; acc[6] += s1[2] * w[kk]; acc[7] += s1[3] * w[kk];
                }
            }
#pragma unroll
            for (int b = 0; b < 8; ++b) red[(wave * 8 + b) * 64 + lane] = acc[b];
            __syncthreads();
            { const int b = tid >> 6; float s = 0.f;
#pragma unroll
              for (int w = 0; w < 8; ++w) s += red[(w * 8 + b) * 64 + lane];
              mod[(size_t)b * NMOD + j] = s + ba[j]; }
            __syncthreads();
        }
    }
    __syncthreads();
    __syncthreads();
    transpose_queue(a, lds, lane, wave, 0);
}

template <bool IN_BF16>
__device__ __forceinline__ void norm_phase(const void* Xv, const float* g, const float* mod, int sub, bf16* outb, float* outf, int gw, int NGW, int lane) {
    for (int rb = gw; rb < T / 8; rb += NGW) {
        const int b = rb / (SEQ / 8);
        f32x4 A[8], S[8];
#pragma unroll
        for (int j = 0; j < 8; ++j) {
            const int c4 = (64 * j + lane) * 4;
            A[j] = *(const f32x4*)(g + c4);
            if (mod) { const float* mp = mod + (size_t)b * NMOD + (sub * 3) * D + c4; S[j] = *(const f32x4*)(mp); A[j] = A[j] * (*(const f32x4*)(mp + D) + 1.0f); }
            else S[j] = (f32x4){0.f, 0.f, 0.f, 0.f};
        }
        for (int r = 0; r < 8; ++r) {
            const size_t row = (size_t)rb * 8 + r;
            f32x4 v[8]; float ss = 0.f;
#pragma unroll
            for (int j = 0; j < 8; ++j) {
                if (IN_BF16) { const u32x2 w = *(const u32x2*)((const bf16*)Xv + row * D + (64 * j + lane) * 4); v[j] = (f32x4){bf_lo(w.x), bf_hi(w.x), bf_lo(w.y), bf_hi(w.y)}; }
                else v[j] = *(const f32x4*)((const float*)Xv + row * D + (64 * j + lane) * 4);
                ss += (v[j][0] * v[j][0] + v[j][1] * v[j][1]) + (v[j][2] * v[j][2] + v[j][3] * v[j][3]); }
            const float rstd = rsqrtf(wave_sum(ss) * (1.0f / D) + EPS);
#pragma unroll
            for (int j = 0; j < 8; ++j) {
                const f32x4 o = v[j] * rstd * A[j] + S[j];
                if (mod) { u32x2 w; w.x = cvt_pk_bf16(o[0], o[1]); w.y = cvt_pk_bf16(o[2], o[3]); *(u32x2*)(outb + row * D + (64 * j + lane) * 4) = w; }
                else *(f32x4*)(outf + row * D + (64 * j + lane) * 4) = o;
            }
        }
    }
}

__device__ __forceinline__ int att_off(int row, int ch) { const int a = (row >> 1) & 7, x = ((a & 1) << 2) | (a >> 1); return row * 128 + ((ch ^ x) << 4); }
__device__ __forceinline__ int crow(int r, int hi) { return (r & 3) + 8 * (r >> 2) + 4 * hi; }

struct AttUnit { int mode, type, head, dil, tok0, q0, qcol, kcol, vcol; };
__device__ __forceinline__ AttUnit att_decode_pair(int u) {
    AttUnit x; x.mode = 0; x.type = u >> 11; const int rem = u & 2047; x.head = rem & 15; const int qg = rem >> 4;
    x.dil = x.type <= 1 ? 1 : (x.type == 2 ? 4 : 16); const int nb = 16 / x.dil, seq = qg / nb, blk = qg % nb, b = seq / x.dil, rr = seq % x.dil;
    x.tok0 = b * SEQ + rr; x.q0 = blk * 128;
    x.qcol = 1280 + x.head * 64; x.kcol = 2304 + x.head * 64; x.vcol = 3328 + x.head * 64;
    return x;
}
__device__ __forceinline__ AttUnit att_decode_gqa(int g, int wave) {
    AttUnit x; x.mode = 1; x.type = 0; const int kvh = g & 1, qb = (g >> 1) & 63, b = g >> 7;
    x.head = 8 * kvh + wave; x.dil = 1; x.tok0 = b * SEQ; x.q0 = qb * 32;
    x.qcol = x.head * 64; x.kcol = 1024 + kvh * 64; x.vcol = 1152 + kvh * 64;
    return x;
}
__device__ __forceinline__ AttUnit att_decode_wide(int w) {
    AttUnit x; x.mode = 2; x.type = 1 + (w >> 10); const int rem = w & 1023; x.head = rem & 15; const int qg = rem >> 4;
    x.dil = x.type == 1 ? 1 : 4; const int nb = 8 / x.dil, seq = qg / nb, blk = qg % nb, b = seq / x.dil, rr = seq % x.dil;
    x.tok0 = b * SEQ + rr; x.q0 = blk * 256;
    x.qcol = 1280 + x.head * 64; x.kcol = 2304 + x.head * 64; x.vcol = 3328 + x.head * 64;
    return x;
}
__device__ __forceinline__ AttUnit att_unit_of(int it, int nG, int nW, int G, int half, int wave, int mapx, int mapy) {
    if (G == 256) {
        if (it < 4) { const int n = mapy * 4 + it; return att_decode_gqa((mapx << 7) | ((n >> 1) << 1) | (n & 1), wave); }
        if (it < 12) { const int n = mapy * 8 + (it - 4), ty = n & 1, r = n >> 1, head = r & 15, q = r >> 4; return att_decode_wide((ty << 10) | ((mapx * 8 + q) << 4) | head); }
        const int n = mapy * 4 + (it - 12), rr = n >> 3, hp = n & 7;
        return att_decode_pair(3 * 2048 + (mapx * 16 + rr) * 16 + 2 * hp + half);
    }
    if (it < nG) return att_decode_gqa((int)blockIdx.x + it * G, wave);
    if (it < nG + nW) return att_decode_wide((int)blockIdx.x + (it - nG) * G);
    const int p = (int)blockIdx.x + (it - nG - nW) * G;
    return att_decode_pair(3 * 2048 + 2 * p + half);
}
__device__ __forceinline__ void att_issue(const bf16* P, const AttUnit& x, u32x4 (&kr)[8], u32x4 (&vr)[8], int tid, int htid) {
    const long vdelta = (long)(x.vcol - x.kcol) * 2;
    if (x.mode == 1) {
        const char* sb = (const char*)P + ((long)(x.tok0 + x.q0 - 128) * NIN + x.kcol) * 2;
        const unsigned voff = (unsigned)((tid >> 3) * NIN + (tid & 7) * 8) * 2u;
        const long istride = (long)64 * NIN * 2;
#pragma unroll
        for (int i = 0; i < 3; ++i) {
            if (i < 2 || tid < 256) { kr[i] = *(const u32x4*)(sb + i * istride + voff); vr[i] = *(const u32x4*)(sb + vdelta + i * istride + voff); }
            else { kr[i] = (u32x4){0u, 0u, 0u, 0u}; vr[i] = kr[i]; }
        }
#pragma unroll
        for (int i = 3; i < 8; ++i) { kr[i] = (u32x4){0u, 0u, 0u, 0u}; vr[i] = kr[i]; }
    } else if (x.mode == 2) {
        const char* sb = (const char*)P + ((long)(x.tok0 + (x.q0 - 128) * x.dil) * NIN + x.kcol) * 2;
        const unsigned voff = (unsigned)(((tid >> 3) * x.dil) * NIN + (tid & 7) * 8) * 2u;
        const long istride = (long)64 * x.dil * NIN * 2;
#pragma unroll
        for (int i = 0; i < 6; ++i) { kr[i] = *(const u32x4*)(sb + i * istride + voff); vr[i] = *(const u32x4*)(sb + vdelta + i * istride + voff); }
#pragma unroll
        for (int i = 6; i < 8; ++i) { kr[i] = (u32x4){0u, 0u, 0u, 0u}; vr[i] = kr[i]; }
    } else {
        const char* sb = (const char*)P + ((long)(x.tok0 + (x.q0 - 128) * x.dil) * NIN + x.kcol) * 2;
        const unsigned voff = (unsigned)(((htid >> 3) * x.dil) * NIN + (htid & 7) * 8) * 2u;
        const long istride = (long)32 * x.dil * NIN * 2;
        const bool skip4 = x.q0 == 0;
#pragma unroll
        for (int i = 0; i < 8; ++i) {
            if (i < 4 && skip4) { kr[i] = (u32x4){0u, 0u, 0u, 0u}; vr[i] = kr[i]; }
            else { kr[i] = *(const u32x4*)(sb + i * istride + voff); vr[i] = *(const u32x4*)(sb + vdelta + i * istride + voff); }
        }
    }
}
__device__ __forceinline__ void att_issue_q(const bf16* P, const AttUnit& x, bf16x8 (&qf)[4], int hw, int wave, int r32, int hi) {
    const int hwe = x.mode == 1 ? 0 : (x.mode == 2 ? wave : hw);
    const char* sq = (const char*)P + ((long)(x.tok0 + (x.q0 + 32 * hwe) * x.dil) * NIN + x.qcol) * 2;
    const unsigned qoff = (unsigned)((r32 * x.dil) * NIN + 8 * hi) * 2u;
#pragma unroll
    for (int s = 0; s < 4; ++s) qf[s] = *(const bf16x8*)(sq + 32 * s + qoff);
}

__device__ __forceinline__ void attn_phase(const Args& a, LAS unsigned char* lds, int tid, int lane, int wave, int G, int mapx, int mapy) {
    unsigned char* ws = a.ws;
    const bf16* P = (const bf16*)(ws + WS_PROJ);
    const int half = wave >> 2, hw = wave & 3, htid = tid & 255, r32 = lane & 31, hi = lane >> 5;
    LAS unsigned char* Kl = lds + half * 65536; LAS unsigned char* Vl = Kl + 32768;
    const float C2 = 0.125f * 1.4426950408889634f;
    const int blk16 = (lane >> 4) & 1, qq = (lane & 15) >> 2, pp = lane & 3;
    const int bx = (int)blockIdx.x;
    const int nG = bx < 1024 ? (1024 - 1 - bx) / G + 1 : 0, nW = bx < 2048 ? (2048 - 1 - bx) / G + 1 : 0, nP = bx < 1024 ? (1024 - 1 - bx) / G + 1 : 0, niter = nG + nW + nP;
    if (niter == 0) return;
    u32x4 kr[8], vr[8]; bf16x8 qn[4];
    AttUnit cur = att_unit_of(0, nG, nW, G, half, wave, mapx, mapy);
    att_issue(P, cur, kr, vr, tid, htid); att_issue_q(P, cur, qn, hw, wave, r32, hi);
    for (int it = 0; it < niter; ++it) {
        asm volatile("s_waitcnt lgkmcnt(0)\n\ts_barrier" ::: "memory");
        if (cur.mode == 1) {
#pragma unroll
            for (int i = 0; i < 3; ++i) { const int idx = i * 512 + tid, row = idx >> 3, ch = idx & 7; const int o = att_off(row, ch);
                if (i < 2 || tid < 256) { *(LAS u32x4*)(lds + o) = kr[i]; *(LAS u32x4*)(lds + 32768 + o) = vr[i]; } }
        } else if (cur.mode == 2) {
#pragma unroll
            for (int i = 0; i < 6; ++i) { const int idx = i * 512 + tid, row = idx >> 3, ch = idx & 7; const int o = att_off(row, ch); *(LAS u32x4*)(lds + o) = kr[i]; *(LAS u32x4*)(lds + 49152 + o) = vr[i]; }
        } else {
#pragma unroll
            for (int i = 0; i < 8; ++i) { const int idx = i * 256 + htid, row = idx >> 3, ch = idx & 7; const int o = att_off(row, ch); *(LAS u32x4*)(Kl + o) = kr[i]; *(LAS u32x4*)(Vl + o) = vr[i]; }
        }
        bf16x8 qf[4];
#pragma unroll
        for (int s = 0; s < 4; ++s) qf[s] = qn[s];
        asm volatile("s_waitcnt lgkmcnt(0)\n\ts_barrier" ::: "memory");
        const AttUnit x = cur;
        if (it + 1 < niter) { cur = att_unit_of(it + 1, nG, nW, G, half, wave, mapx, mapy); att_issue(P, cur, kr, vr, tid, htid); att_issue_q(P, cur, qn, hw, wave, r32, hi); }
        const int hwe = x.mode == 1 ? 0 : (x.mode == 2 ? wave : hw);
        LAS unsigned char* Kb = x.mode == 0 ? Kl : lds; LAS unsigned char* Vb = Kb + (x.mode == 2 ? 49152 : 32768);
        LAS unsigned char* kx[4]; LAS unsigned char* vx[2][2];
#pragma unroll
        for (int s = 0; s < 4; ++s) kx[s] = Kb + att_off(32 * hwe + r32, 2 * s + hi);
#pragma unroll
        for (int t = 0; t < 2; ++t)
#pragma unroll
            for (int c = 0; c < 2; ++c) vx[t][c] = Vb + att_off(32 * hwe + 4 * hi + qq + 8 * t, 4 * c + 2 * blk16 + (pp >> 1)) + 8 * (pp & 1);
        const int ql = 128 + 32 * hwe + r32;
        const int maxd = x.type == 0 ? 127 : 128;
        const float sink2 = x.type == 0 ? a.in[11][x.head] * 1.4426950408889634f : -INFINITY;
        float m = sink2, lsum = 0.f;
        f32x16 o[2]; o[0] = f32x16{}; o[1] = f32x16{};
#pragma unroll
        for (int ti = 4; ti >= 0; --ti) {
            const int tl = hwe + ti; const bool valid = (x.q0 - 128 + 32 * tl) >= 0;
            if (valid) {
                f32x16 acc = {};
#pragma unroll
                for (int s = 0; s < 4; ++s) { const bf16x8 kf = *(const LAS bf16x8*)(kx[s] + ti * 4096); acc = __builtin_amdgcn_mfma_f32_32x32x16_bf16(kf, qf[s], acc, 0, 0, 0); }
                float p[16]; float tmax = -INFINITY;
                if (ti == 4 || ti == 0) {
#pragma unroll
                    for (int r = 0; r < 16; ++r) { const int dd = ql - (32 * tl + crow(r, hi)); const bool ok = dd >= 0 && dd <= maxd; p[r] = ok ? acc[r] * C2 : -INFINITY; tmax = fmaxf(tmax, p[r]); }
                } else {
#pragma unroll
                    for (int r = 0; r < 16; ++r) { p[r] = acc[r] * C2; tmax = fmaxf(tmax, p[r]); }
                }
                tmax = fmaxf(tmax, __shfl_xor(tmax, 32));
                const float mnew = fmaxf(m, tmax);
                if (__any(mnew > m)) {
                    const float alpha = __builtin_amdgcn_exp2f(m - mnew);
                    lsum *= alpha;
#pragma unroll
                    for (int r = 0; r < 16; ++r) { o[0][r] *= alpha; o[1][r] *= alpha; }
                }
                m = mnew;
#pragma unroll
                for (int r = 0; r < 16; ++r) { p[r] = __builtin_amdgcn_exp2f(p[r] - mnew); lsum += p[r]; }
#pragma unroll
                for (int sp = 0; sp < 2; ++sp) {
                    u32x4 pw; pw.x = cvt_pk_bf16(p[8 * sp + 0], p[8 * sp + 1]); pw.y = cvt_pk_bf16(p[8 * sp + 2], p[8 * sp + 3]); pw.z = cvt_pk_bf16(p[8 * sp + 4], p[8 * sp + 5]); pw.w = cvt_pk_bf16(p[8 * sp + 6], p[8 * sp + 7]);
                    const bf16x8 pb = __builtin_bit_cast(bf16x8, pw);
#pragma unroll
                    for (int c = 0; c < 2; ++c) {
                        const s16x4 v0 = __builtin_bit_cast(s16x4, __builtin_amdgcn_ds_read_tr16_b64_v4i16((LAS s16x4*)(vx[0][c] + ti * 4096 + sp * 2048)));
                        const s16x4 v1 = __builtin_bit_cast(s16x4, __builtin_amdgcn_ds_read_tr16_b64_v4i16((LAS s16x4*)(vx[1][c] + ti * 4096 + sp * 2048)));
                        const bf16x8 vf = (bf16x8){v0[0], v0[1], v0[2], v0[3], v1[0], v1[1], v1[2], v1[3]};
                        o[c] = __builtin_amdgcn_mfma_f32_32x32x16_bf16(vf, pb, o[c], 0, 0, 0);
                    }
                }
            }
        }
        lsum += __shfl_xor(lsum, 32);
        if (x.type == 0) lsum += __builtin_amdgcn_exp2f(sink2 - m);
        const float inv = 1.0f / lsum;
        const size_t qtok = (size_t)(x.tok0 + (x.q0 + 32 * hwe + r32) * x.dil);
        bf16* outp = x.type == 0 ? (bf16*)(ws + WS_OA) : (bf16*)(ws + WS_OB) + (size_t)(x.type - 1) * T * 1024;
        bf16* op = outp + qtok * 1024 + x.head * 64 + 4 * hi;
#pragma unroll
        for (int c = 0; c < 2; ++c)
#pragma unroll
            for (int gq = 0; gq < 4; ++gq) { u32x2 w; w.x = cvt_pk_bf16(o[c][4 * gq] * inv, o[c][4 * gq + 1] * inv); w.y = cvt_pk_bf16(o[c][4 * gq + 2] * inv, o[c][4 * gq + 3] * inv); *(u32x2*)(op + 32 * c + 8 * gq) = w; }
        if (x.type != 0 && hi == 0) { float* lsep = (float*)(ws + WS_LSE) + (size_t)(x.type - 1) * T * 16; lsep[qtok * 16 + x.head] = (m + __log2f(lsum)) * 0.6931471805599453f; }
    }
}

__device__ __forceinline__ void combine_phase(const Args& a, int t0, int tstride, int tcnt, int lane) {
    unsigned char* ws = a.ws;
    const bf16* OA = (const bf16*)(ws + WS_OA); const bf16* OB = (const bf16*)(ws + WS_OB); const float* LSE = (const float*)(ws + WS_LSE); bf16* Y = (bf16*)(ws + WS_A);
    const float* ga = a.in[12] + 16 * lane; const float* gb = a.in[13] + 16 * lane;
    float GA[16], GB[16];
#pragma unroll
    for (int i = 0; i < 4; ++i) { const f32x4 x = *(const f32x4*)(ga + 4 * i), y = *(const f32x4*)(gb + 4 * i);
#pragma unroll
        for (int j = 0; j < 4; ++j) { GA[4 * i + j] = x[j]; GB[4 * i + j] = y[j]; } }
    for (int ti_ = 0; ti_ < tcnt; ++ti_) {
        const int tok = t0 + ti_ * tstride;
        float v[16];
        {
            const u32x4 w0 = *(const u32x4*)(OA + (size_t)tok * 1024 + 16 * lane), w1 = *(const u32x4*)(OA + (size_t)tok * 1024 + 16 * lane + 8);
#pragma unroll
            for (int i = 0; i < 4; ++i) { v[2 * i] = bf_lo(w0[i]); v[2 * i + 1] = bf_hi(w0[i]); v[8 + 2 * i] = bf_lo(w1[i]); v[8 + 2 * i + 1] = bf_hi(w1[i]); }
            float ss = 0.f;
#pragma unroll
            for (int i = 0; i < 16; ++i) ss += v[i] * v[i];
            const float rstd = rsqrtf(wave_sum(ss) * (1.0f / 1024.0f) + EPS);
            u32x4 o0, o1;
#pragma unroll
            for (int i = 0; i < 4; ++i) { o0[i] = cvt_pk_bf16(v[2 * i] * rstd * GA[2 * i], v[2 * i + 1] * rstd * GA[2 * i + 1]); o1[i] = cvt_pk_bf16(v[8 + 2 * i] * rstd * GA[8 + 2 * i], v[9 + 2 * i] * rstd * GA[9 + 2 * i]); }
            *(u32x4*)(Y + (size_t)tok * D + 16 * lane) = o0; *(u32x4*)(Y + (size_t)tok * D + 16 * lane + 8) = o1;
        }
        {
            const int h = lane >> 2;
            const float l0 = LSE[(size_t)tok * 16 + h], l1 = LSE[(size_t)T * 16 + (size_t)tok * 16 + h], l2 = LSE[(size_t)2 * T * 16 + (size_t)tok * 16 + h];
            const float m = fmaxf(l0, fmaxf(l1, l2)); float e0 = __expf(l0 - m), e1 = __expf(l1 - m), e2 = __expf(l2 - m); const float is = 1.0f / (e0 + e1 + e2);
            const float wgt[3] = {e0 * is, e1 * is, e2 * is};
#pragma unroll
            for (int i = 0; i < 16; ++i) v[i] = 0.f;
#pragma unroll
            for (int c = 0; c < 3; ++c) {
                const bf16* src = OB + (size_t)c * T * 1024 + (size_t)tok * 1024 + 16 * lane;
                const u32x4 w0 = *(const u32x4*)(src), w1 = *(const u32x4*)(src + 8);
#pragma unroll
                for (int i = 0; i < 4; ++i) { v[2 * i] += wgt[c] * bf_lo(w0[i]); v[2 * i + 1] += wgt[c] * bf_hi(w0[i]); v[8 + 2 * i] += wgt[c] * bf_lo(w1[i]); v[9 + 2 * i] += wgt[c] * bf_hi(w1[i]); }
            }
            float ss = 0.f;
#pragma unroll
            for (int i = 0; i < 16; ++i) ss += v[i] * v[i];
            const float rstd = rsqrtf(wave_sum(ss) * (1.0f / 1024.0f) + EPS);
            u32x4 o0, o1;
#pragma unroll
            for (int i = 0; i < 4; ++i) { o0[i] = cvt_pk_bf16(v[2 * i] * rstd * GB[2 * i], v[2 * i + 1] * rstd * GB[2 * i + 1]); o1[i] = cvt_pk_bf16(v[8 + 2 * i] * rstd * GB[8 + 2 * i], v[9 + 2 * i] * rstd * GB[9 + 2 * i]); }
            *(u32x4*)(Y + (size_t)tok * D + 1024 + 16 * lane) = o0; *(u32x4*)(Y + (size_t)tok * D + 1024 + 16 * lane + 8) = o1;
        }
    }
}

#define XB_TMO      128
#define XB_XCNT(j)  (256  + 64 * (j))
#define XB_XSUB(j)  (1280 + 64 * (j))
#define XB_XGEN(j)  (2304 + 64 * (j))
#define XB_TOP      3328
#define XB_TOPGEN   3392
#define XCD_BAR_WORDS 3456
#define XB_SPIN_CAP (1u << 24)

__device__ __forceinline__ unsigned xb_ld(unsigned* p)              { return __hip_atomic_load(p, __ATOMIC_RELAXED, __HIP_MEMORY_SCOPE_AGENT); }
__device__ __forceinline__ unsigned xb_add(unsigned* p, unsigned v) { return __hip_atomic_fetch_add(p, v, __ATOMIC_RELAXED, __HIP_MEMORY_SCOPE_AGENT); }
__device__ __forceinline__ unsigned xb_xcc_id() { return (unsigned)__builtin_amdgcn_s_getreg((3 << 11) | 20) & 0xFu; }
#define XB_SPIN(cond, bar) do { unsigned _sp = 0; while (cond) { __builtin_amdgcn_s_sleep(1); \
    if ((++_sp & 255u) == 0u) { if (xb_ld(&(bar)[XB_TMO])) break; if (_sp > XB_SPIN_CAP) { atomicAdd(&(bar)[XB_TMO], 1u); break; } } } } while (0)

struct XcdBarrier {
    unsigned* bar; unsigned x;
    volatile LAS unsigned* st;
};

__device__ __forceinline__ XcdBarrier xcd_barrier_post(unsigned* bar, volatile LAS unsigned* st) {
    XcdBarrier b; b.bar = bar; b.x = xb_xcc_id(); b.st = st;
    if (threadIdx.x == 0) st[3] = xb_add(&bar[XB_XCNT(b.x)], 1u);
    return b;
}
__device__ __forceinline__ void xcd_barrier_complete(unsigned* bar, unsigned x, unsigned& nloc, unsigned& nx) {
    const unsigned G = gridDim.x * gridDim.y * gridDim.z;
    unsigned sum, cnt, mine, sp = 0u;
    for (;;) {
        sum = 0u; cnt = 0u; mine = 0u;
#pragma unroll
        for (unsigned j = 0; j < 16; ++j) { const unsigned c = xb_ld(&bar[XB_XCNT(j)]); sum += c; cnt += (c > 0u) ? 1u : 0u; mine = (j == x) ? c : mine; }
        if (sum == G) break;
        __builtin_amdgcn_s_sleep(1);
        if ((++sp & 255u) == 0u) { if (xb_ld(&bar[XB_TMO])) break; if (sp > XB_SPIN_CAP) { atomicAdd(&bar[XB_TMO], 1u); break; } }
    }
    nloc = mine > 0u ? mine : 1u; nx = cnt > 0u ? cnt : 1u;
}

__device__ __forceinline__ void xcd_barrier(const XcdBarrier& b) {
    asm volatile("s_waitcnt vmcnt(0)" ::: "memory");
    __syncthreads();
    if (threadIdx.x == 0) {
        unsigned* bar = b.bar;
        __builtin_amdgcn_s_waitcnt(0);
        unsigned nloc = b.st[0], nx = b.st[1];
        if (nloc == 0u) { xcd_barrier_complete(bar, b.x, nloc, nx); b.st[0] = nloc; b.st[1] = nx; }
        const unsigned old = xb_add(&bar[XB_XSUB(b.x)], 1u);
        const unsigned gen = old / nloc;
        if (old + 1u == (gen + 1u) * nloc) {
            __builtin_amdgcn_fence(__ATOMIC_RELEASE, "agent");
            asm volatile("s_waitcnt vmcnt(0)" ::: "memory");
            const unsigned og = xb_add(&bar[XB_TOP], 1u);
            const unsigned tg = og / nx;
            if (og + 1u == (tg + 1u) * nx) xb_add(&bar[XB_TOPGEN], 1u);
            else XB_SPIN(xb_ld(&bar[XB_TOPGEN]) == tg, bar);
            __builtin_amdgcn_fence(__ATOMIC_ACQUIRE, "agent");
            xb_add(&bar[XB_XGEN(b.x)], 1u);
            asm volatile("s_waitcnt vmcnt(0)" ::: "memory");
        } else {
            XB_SPIN(xb_ld(&bar[XB_XGEN(b.x)]) == gen, bar);
            __builtin_amdgcn_fence(__ATOMIC_ACQUIRE, "agent");
            asm volatile("s_waitcnt vmcnt(0)" ::: "memory");
        }
    }
    __syncthreads();
}


__device__ __forceinline__ void xcd_barrier_local(const XcdBarrier& b) {
    asm volatile("s_waitcnt vmcnt(0)" ::: "memory");
    __syncthreads();
    if (threadIdx.x == 0) {
        unsigned* bar = b.bar;
        __builtin_amdgcn_s_waitcnt(0);
        const unsigned nloc = b.st[0];
        const unsigned old = xb_add(&bar[XB_XSUB(b.x)], 1u);
        const unsigned gen = old / nloc;
        if (old + 1u == (gen + 1u) * nloc) xb_add(&bar[XB_XGEN(b.x)], 1u);
        else XB_SPIN(xb_ld(&bar[XB_XGEN(b.x)]) == gen, bar);
        __builtin_amdgcn_fence(__ATOMIC_ACQUIRE, "agent");
        asm volatile("s_waitcnt vmcnt(0)" ::: "memory");
    }
    __syncthreads();
}

__global__ void __launch_bounds__(512, 2) mk_fwd(Args a) {
    extern __shared__ __attribute__((aligned(16))) unsigned char lds_raw[];
    LAS unsigned char* lds = (LAS unsigned char*)lds_raw;
    const int tid = threadIdx.x, lane = tid & 63, wave = __builtin_amdgcn_readfirstlane(tid >> 6);
    const int G = gridDim.x, gw = blockIdx.x * 8 + wave, NGW = G * 8;
    unsigned char* ws = a.ws;
    bf16* Abuf = (bf16*)(ws + WS_A); bf16* U = (bf16*)(ws + WS_U); bf16* XB = (bf16*)(ws + WS_XB); const float* mod = (const float*)(ws + WS_MOD);
#ifndef PHM
#define PHM 0xffff
#endif
#define HAS(k) ((PHM >> (k)) & 1)
    const int lo = a.ph_lo, hi = a.ph_hi;
    volatile LAS unsigned* MISC = (volatile LAS unsigned*)(lds + LDS_BYTES - 256);
    if (tid < 64) MISC[tid] = 0u;
    __syncthreads();
    XcdBarrier xbar; xbar.bar = (unsigned*)(ws + WS_CTL + 16384); xbar.x = 0; xbar.st = nullptr;
    if (hi - lo > 1) xbar = xcd_barrier_post((unsigned*)(ws + WS_CTL + 16384), MISC + 8);
#ifndef REPM
#define REPM 0
#endif
#define REP(k) (((REPM >> (k)) & 1) ? 2 : 1)
#define IN(k) (HAS(k) && lo <= (k) && (k) < hi)
    int mapx = (int)blockIdx.x & 7, mapy = (int)blockIdx.x >> 3; bool lok = false;
#define SEAM_LOCAL_MASK 0xDF6
#define SEAM(k) do { if ((k) + 1 < hi && lo <= (k)) { if (lok && ((SEAM_LOCAL_MASK >> (k)) & 1)) xcd_barrier_local(xbar); else xcd_barrier(xbar); } } while (0)
#define NORM_PH(k, BF, Xp, gp, sub) if (IN(k)) for (int rep_ = 0; rep_ < REP(k); ++rep_) { norm_phase<BF>(Xp, gp, mod, sub, Abuf, nullptr, gwm, NGW, lane); } SEAM(k)
#define SWIGLU_PH(k, WOFF) if (IN(k)) for (int rep_ = 0; rep_ < REP(k); ++rep_) { pg8::Gemm g{Abuf, (const bf16*)(ws + (WOFF)), T, 2 * FF, D}; pg8::StaticOrder S; S.init(T, 2 * FF, G, vc); \
        pg8::EpiSwiglu E{U, FF}; pg8::gemm_phase<pg8::EpiSwiglu, pg8::StaticOrder, GEMM_ALIGN, GEMM_SP2>(lds, g, S, E); } SEAM(k)
#define RESID_PH(k, BF, Ap, WOFF, KK, basep, biasp, sub, gs) if (IN(k)) for (int rep_ = 0; rep_ < REP(k); ++rep_) { pg8::Gemm g{Ap, (const bf16*)(ws + (WOFF)), T, D, KK}; pg8::StaticOrder S; S.init(T, D, G, vc); \
        pg8::EpiResid<BF> E{basep, XB, biasp, mod + ((sub) * 3 + 2) * D, gs, D, NMOD}; pg8::gemm_phase<pg8::EpiResid<BF>, pg8::StaticOrder, GEMM_ALIGN, GEMM_SP2>(lds, g, S, E); } SEAM(k)
    if (hi > 1000) cg::this_grid().sync();
    if (IN(0)) for (int rep_ = 0; rep_ < REP(0); ++rep_) { p0_prep(a, lds, tid, lane, wave, G, rep_); __syncthreads(); }
    SEAM(0);
    if (lo == 0 && hi > 1 && G == 256) {
        if (tid == 0) { unsigned okk = 1u; const unsigned* bw = xbar.bar;
#pragma unroll
            for (unsigned j = 0; j < 16; ++j) { const unsigned cnt = __hip_atomic_load(bw + XB_XCNT(j), __ATOMIC_RELAXED, __HIP_MEMORY_SCOPE_AGENT); okk &= (cnt == (j < 8 ? 32u : 0u)) ? 1u : 0u; }
            MISC[10] = okk; }
        __syncthreads();
        lok = MISC[10] != 0u;
        if (lok) { mapx = (int)xbar.x; mapy = (int)MISC[11]; }
    }
    const bool g256 = G == 256;
    const int vc = g256 ? mapy * 8 + mapx : (int)blockIdx.x;
    const int gwm = g256 ? mapx * 256 + mapy * 8 + wave : gw;
    NORM_PH(1, false, a.in[0], a.in[5], 0);
    SWIGLU_PH(2, WS_WGU1);
    RESID_PH(3, false, U, WS_WD1, FF, a.in[0], nullptr, 0, 0.5f);
    NORM_PH(4, true, XB, a.in[8], 1);
    if (IN(5)) for (int rep_ = 0; rep_ < REP(5); ++rep_) {
        pg8::Gemm g{Abuf, (const bf16*)(ws + WS_WIN), T, NIN, D}; pg8::StaticOrder S; S.init(T, NIN, G, vc);
        pg8::EpiQKV E{(bf16*)(ws + WS_PROJ), a.in[10], (const float*)(ws + WS_ROPE), NIN};
        pg8::gemm_phase<pg8::EpiQKV, pg8::StaticOrder, GEMM_ALIGN, GEMM_SP2>(lds, g, S, E);
        __syncthreads();
        transpose_queue(a, lds, lane, wave, 1);
    }
    SEAM(5);
    if (IN(6)) for (int rep_ = 0; rep_ < REP(6); ++rep_) attn_phase(a, lds, tid, lane, wave, G, mapx, mapy);
    SEAM(6);
    if (IN(7)) for (int rep_ = 0; rep_ < REP(7); ++rep_) combine_phase(a, g256 ? 2048 * mapx + mapy * 8 + wave : gw, g256 ? 256 : NGW, g256 ? 8 : (T - gw + NGW - 1) / NGW, lane);
    SEAM(7);
    RESID_PH(8, true, Abuf, WS_WOUT, D, XB, a.in[15], 1, 1.0f);
    NORM_PH(9, true, XB, a.in[16], 2);
    SWIGLU_PH(10, WS_WGU2);
    RESID_PH(11, true, U, WS_WD2, FF, XB, nullptr, 2, 0.5f);
    if (IN(12)) norm_phase<true>(XB, a.in[19], nullptr, 0, nullptr, a.out, gwm, NGW, lane);
}

extern "C" void kernel_launch(void* const* d_in, const int* in_sizes, int n_in, void* d_out, int out_size, void* d_ws, size_t ws_size, hipStream_t stream) {
    static int grid = 0;
    if (grid == 0) {
        if (n_in != 20 || in_sizes[0] != T * D || out_size != T * D || ws_size < WS_END) { fprintf(stderr, "kernel_launch: unexpected shapes / workspace (n_in %d, in0 %d, out %d, ws %zu < %zu)\n", n_in, n_in > 0 ? in_sizes[0] : -1, out_size, ws_size, (size_t)WS_END); grid = -1; return; }
        int dev = 0, cus = 0, per_cu = 0;
        if (hipGetDevice(&dev) != hipSuccess || hipDeviceGetAttribute(&cus, hipDeviceAttributeMultiprocessorCount, dev) != hipSuccess) { grid = -1; return; }
        if (hipFuncSetAttribute((const void*)mk_fwd, hipFuncAttributeMaxDynamicSharedMemorySize, LDS_BYTES) != hipSuccess) { fprintf(stderr, "kernel_launch: hipFuncSetAttribute failed\n"); grid = -1; return; }
        if (hipOccupancyMaxActiveBlocksPerMultiprocessor(&per_cu, (const void*)mk_fwd, 512, LDS_BYTES) != hipSuccess || per_cu < 1) { fprintf(stderr, "kernel_launch: occupancy query says %d\n", per_cu); per_cu = 1; }
        (void)hipGetLastError();
        grid = cus * per_cu;
    }
    if (grid < 0) return;
    (void)hipMemsetAsync((char*)d_ws + WS_CTL, 0, 65536, stream);
    Args a{};
    for (int i = 0; i < 20; ++i) a.in[i] = (const float*)d_in[i];
    a.out = (float*)d_out; a.ws = (unsigned char*)d_ws;
    for (int i = 0; i < 8; ++i) a.invf[i] = powf(500000.0f, -((float)(2 * i) / 16.0f));
#if MK_MULTI
#ifndef DBG_LAST
#define DBG_LAST (NPH - 1)
#endif
    for (int ph = 0; ph <= DBG_LAST; ++ph) {
#ifdef DBG_SKIP
        if ((DBG_SKIP >> ph) & 1) continue;
#endif
        a.ph_lo = ph; a.ph_hi = ph + 1; hipLaunchKernelGGL(mk_fwd, dim3(grid), dim3(512), LDS_BYTES, stream, a); }
#else
    a.ph_lo = 0; a.ph_hi = NPH;
    void* args[] = {&a};
    hipError_t e = hipLaunchCooperativeKernel((const void*)mk_fwd, dim3(grid), dim3(512), args, LDS_BYTES, stream);
    if (e != hipSuccess) fprintf(stderr, "cooperative launch failed: %s (grid %d)\n", hipGetErrorString(e), grid);
#endif
}
```

```cpp
#include <hip/hip_runtime.h>
#include <hip/hip_cooperative_groups.h>
#include <cstdio>
#include <cstdint>
#include <cmath>
namespace cg = cooperative_groups;
#ifndef MK_MULTI
#define MK_MULTI 0
#ifndef GEMM_ALIGN
#define GEMM_ALIGN true
#endif
#ifndef GEMM_SP2
#define GEMM_SP2 true
#endif
#endif
namespace pg8 {
#define PG8_LAS __attribute__((address_space(3)))
typedef unsigned short bf16_t;
typedef short bf16x8 __attribute__((ext_vector_type(8)));
typedef float f32x4 __attribute__((ext_vector_type(4)));
typedef unsigned u32x4 __attribute__((ext_vector_type(4)));
constexpr int BM = 256, BK = 64, HALF = 128, HTB = HALF * BK * 2  , STAGE_BYTES = 8 * HTB, NXCD = 8, WGM = 8;

__host__ __device__ __forceinline__ int lds_byte(int r, int c) { const int st = (r >> 4) * 2 + (c >> 5), rr = r & 15, cc = c & 31, ob = rr * 64 + cc * 2; return st * 1024 + (ob ^ (((ob >> 9) & 1) << 5)); }
__host__ __device__ __forceinline__ void stage_rc(int b, int& R, int& C) { const int st = b / 1024, sb = b % 1024, swz = sb ^ (((sb >> 9) & 1) << 5); R = (st >> 1) * 16 + swz / 64; C = (st & 1) * 32 + (swz % 64) / 2; }
__host__ __device__ __forceinline__ int perm32(int rho) { const int n = rho >> 4, i = rho & 15; return 8 * (i >> 2) + 4 * n + (i & 3); }

struct Unit { int pm, pn; };
struct Gemm { const bf16_t* A; const bf16_t* Bt; int M, N, K; };

struct StaticOrder {
    int nM, nN, nwg, G, c;
    __host__ __device__ void init(int M, int N, int G_, int c_) { nM = M / BM; nN = N / BM; nwg = nM * nN; G = G_; c = c_; }
    __host__ __device__ bool next(int i, Unit& u) const {
        const long L = (long)i * G + c; if (L >= nwg) return false;
        int wgid = (int)L; { const int q = nwg / NXCD, r = nwg % NXCD, xcd = wgid % NXCD, off = wgid / NXCD; wgid = (xcd < r ? xcd * (q + 1) : r * (q + 1) + (xcd - r) * q) + off; }
        const int nig = WGM * nN, gid = wgid / nig, fm = gid * WGM, gsz = (nM - fm) < WGM ? (nM - fm) : WGM;
        u.pm = fm + ((wgid % nig) % gsz); u.pn = (wgid % nig) / gsz; return true;
    }
    __device__ __forceinline__ void a_ready(const Unit&) const {}
    __device__ __forceinline__ void done(const Unit&) const {}
};

typedef float f32x2_t __attribute__((ext_vector_type(2))); typedef __bf16 bf16x2_t __attribute__((ext_vector_type(2)));
__device__ __forceinline__ unsigned cvt_pk_bf16(float lo, float hi) { f32x2_t v = {lo, hi}; bf16x2_t b = __builtin_convertvector(v, bf16x2_t); return __builtin_bit_cast(unsigned, b); }
__device__ __forceinline__ float silu_mul(float g, float u) { return g * u * __builtin_amdgcn_rcpf(1.0f + __builtin_amdgcn_exp2f(-1.4426950408889634f * g)); }

struct EpiSwiglu {
    static constexpr bool PERM = true, AFTER_DRAIN = false;
    bf16_t* O; int ldo;
    __device__ __forceinline__ void operator()(const f32x4 (&acc)[2][2][4][2], const Unit& u, int wr, int wc, int fr, int fq) const {
        const int row0 = u.pm * BM + wr * 64 + fr, col0 = u.pn * HALF + wc * 32 + 8 * fq;
#ifdef PROBE_SWEPI2
      for (int rp_ = 0; rp_ < 2; ++rp_) { asm volatile("" ::: "memory");
#endif
#pragma unroll
        for (int ai = 0; ai < 2; ++ai)
#pragma unroll
            for (int m = 0; m < 4; ++m) {
                bf16_t* p = O + (size_t)(row0 + ai * HALF + m * 16) * ldo + col0;
                const f32x4 g0 = acc[ai][0][m][0], g1 = acc[ai][0][m][1], u0 = acc[ai][1][m][0], u1 = acc[ai][1][m][1];
                u32x4 w;
                w.x = cvt_pk_bf16(silu_mul(g0[0], u0[0]), silu_mul(g0[1], u0[1]));
                w.y = cvt_pk_bf16(silu_mul(g0[2], u0[2]), silu_mul(g0[3], u0[3]));
                w.z = cvt_pk_bf16(silu_mul(g1[0], u1[0]), silu_mul(g1[1], u1[1]));
                w.w = cvt_pk_bf16(silu_mul(g1[2], u1[2]), silu_mul(g1[3], u1[3]));
                *(u32x4*)p = w;
            }
#ifdef PROBE_SWEPI2
      }
#endif
    }
};

template <bool BASE_BF16> struct EpiResid {
    static constexpr bool PERM = true, AFTER_DRAIN = false;
    const void* base; bf16_t* out; const float* bias; const float* gatev; float gs; int ldc, gstride;
    __device__ __forceinline__ void operator()(const f32x4 (&acc)[2][2][4][2], const Unit& u, int wr, int wc, int fr, int fq) const {
        const float* gp = gatev + (size_t)(u.pm >> 3) * gstride;
        const int row0 = u.pm * BM + wr * 64 + fr;
#pragma unroll
        for (int bj = 0; bj < 2; ++bj) {
            const int col0 = u.pn * BM + bj * HALF + wc * 32 + 8 * fq;
            const f32x4 g0 = *(const f32x4*)(gp + col0) * gs, g1 = *(const f32x4*)(gp + col0 + 4) * gs;
            const f32x4 b0 = bias ? *(const f32x4*)(bias + col0) : (f32x4){0.f, 0.f, 0.f, 0.f}, b1 = bias ? *(const f32x4*)(bias + col0 + 4) : (f32x4){0.f, 0.f, 0.f, 0.f};
#pragma unroll
            for (int ai = 0; ai < 2; ++ai)
#pragma unroll
                for (int m = 0; m < 4; ++m) {
                    const size_t off = (size_t)(row0 + ai * HALF + m * 16) * ldc + col0;
                    f32x4 s0, s1;
                    if (BASE_BF16) { const u32x4 w = *(const u32x4*)((const bf16_t*)base + off);
                        s0 = (f32x4){__uint_as_float(w.x << 16), __uint_as_float(w.x & 0xffff0000u), __uint_as_float(w.y << 16), __uint_as_float(w.y & 0xffff0000u)};
                        s1 = (f32x4){__uint_as_float(w.z << 16), __uint_as_float(w.z & 0xffff0000u), __uint_as_float(w.w << 16), __uint_as_float(w.w & 0xffff0000u)}; }
                    else { s0 = *(const f32x4*)((const float*)base + off); s1 = *(const f32x4*)((const float*)base + off + 4); }
                    const f32x4 v0 = s0 + g0 * (acc[ai][bj][m][0] + b0), v1 = s1 + g1 * (acc[ai][bj][m][1] + b1);
                    u32x4 w; w.x = cvt_pk_bf16(v0[0], v0[1]); w.y = cvt_pk_bf16(v0[2], v0[3]); w.z = cvt_pk_bf16(v1[0], v1[1]); w.w = cvt_pk_bf16(v1[2], v1[3]);
                    *(u32x4*)(out + off) = w;
                }
        }
    }
};

struct EpiQKV {
    static constexpr bool PERM = true, AFTER_DRAIN = false;
    bf16_t* O; const float* bias; const float* rope; int ldo;
    __device__ __forceinline__ void operator()(const f32x4 (&acc)[2][2][4][2], const Unit& u, int wr, int wc, int fr, int fq) const {
        const int row0 = u.pm * BM + wr * 64 + fr;
#pragma unroll
        for (int bj = 0; bj < 2; ++bj) {
            const int ch = u.pn * BM + bj * HALF;
            const bool rope_on = ((ch < 1152) || (ch >= 1280 && ch < 3328)) && ((wc & 1) == 0);
            const int col0 = ch + wc * 32 + 8 * fq;
            const f32x4 b0 = *(const f32x4*)(bias + col0), b1 = *(const f32x4*)(bias + col0 + 4);
#pragma unroll
            for (int ai = 0; ai < 2; ++ai)
#pragma unroll
                for (int m = 0; m < 4; ++m) {
                    const int row = row0 + ai * HALF + m * 16;
                    f32x4 x0 = acc[ai][bj][m][0] + b0, x1 = acc[ai][bj][m][1] + b1;
                    if (rope_on) {
                        f32x4 y0, y1;
#pragma unroll
                        for (int i = 0; i < 4; ++i) { y0[i] = __shfl_xor(x0[i], 16); y1[i] = __shfl_xor(x1[i], 16); }
                        if (fq < 2) {
                            const float* rp = rope + (size_t)row * 16;
                            const f32x4 c0 = *(const f32x4*)(rp), c1 = *(const f32x4*)(rp + 4), s0 = *(const f32x4*)(rp + 8), s1 = *(const f32x4*)(rp + 12);
                            if (fq == 0) { x0 = x0 * c0 - y0 * s0; x1 = x1 * c1 - y1 * s1; }
                            else         { x0 = x0 * c0 + y0 * s0; x1 = x1 * c1 + y1 * s1; }
                        }
                    }
                    u32x4 w; w.x = cvt_pk_bf16(x0[0], x0[1]); w.y = cvt_pk_bf16(x0[2], x0[3]); w.z = cvt_pk_bf16(x1[0], x1[1]); w.w = cvt_pk_bf16(x1[2], x1[3]);
                    *(u32x4*)(O + (size_t)row * ldo + col0) = w;
                }
        }
    }
};

template <class Epi, class Sched, bool ALIGN_EPI = false, bool SP2 = false>
__device__ __forceinline__ void gemm_phase(PG8_LAS unsigned char* lds, const Gemm g, const Sched& S, const Epi& E) {
    const int tid = threadIdx.x, wid = __builtin_amdgcn_readfirstlane(tid >> 6), lane = tid & 63, wr = wid >> 2, wc = wid & 3, fr = lane & 15, fq = lane >> 4;
    const int K = g.K, nt = K / BK;
    unsigned voffA[2], voffB[2];
#pragma unroll
    for (int i = 0; i < 2; ++i) { int R, C; stage_rc(tid * 16 + i * 8192, R, C); const int Rb = Epi::PERM ? ((R & ~31) + perm32(R & 31)) : R;
        voffA[i] = (unsigned)(R * K + C) * 2u; voffB[i] = (unsigned)(Rb * K + C) * 2u; }
    const size_t kstep = (size_t)(BK * 2);
    const size_t hstep = (size_t)HALF * K * 2;
    const size_t tstep = 2 * hstep;
    const unsigned ldsw = (unsigned)wid * 1024u;
    const int aoff = lds_byte(wr * 64 + fr, fq * 8), boff = lds_byte(wc * 32 + fr, fq * 8);
#define PG8_SA(b, h) (((b) * 2 + (h)) * HTB)
#define PG8_SB(b, h) ((4 + (b) * 2 + (h)) * HTB)
#define PG8_STAGE(bufoff, gbase, voff) do { _Pragma("unroll") for (int _i = 0; _i < 2; ++_i) \
        __builtin_amdgcn_global_load_lds((const unsigned*)((const char*)(gbase) + (voff)[_i]), (PG8_LAS unsigned*)(lds + (bufoff) + ldsw + _i * 8192), 16, 0, 0); } while (0)
#define PG8_LDA(dst, b, h) do { _Pragma("unroll") for (int m = 0; m < 4; ++m) _Pragma("unroll") for (int k = 0; k < 2; ++k) dst[m][k] = *(const PG8_LAS bf16x8*)(lds + PG8_SA(b, h) + aoff + m * 2048 + k * 1024); } while (0)
#define PG8_LDB(dst, b, h) do { _Pragma("unroll") for (int n = 0; n < 2; ++n) _Pragma("unroll") for (int k = 0; k < 2; ++k) dst[n][k] = *(const PG8_LAS bf16x8*)(lds + PG8_SB(b, h) + boff + n * 2048 + k * 1024); } while (0)
#define PG8_MMA(ai, bj, At, Bt) do { __builtin_amdgcn_s_setprio(1); _Pragma("unroll") for (int m = 0; m < 4; ++m) _Pragma("unroll") for (int n = 0; n < 2; ++n) _Pragma("unroll") for (int k = 0; k < 2; ++k) \
        acc[ai][bj][m][n] = __builtin_amdgcn_mfma_f32_16x16x32_bf16(Bt[n][k], At[m][k], acc[ai][bj][m][n], 0, 0, 0); __builtin_amdgcn_s_setprio(0); } while (0)
#define PG8_WAIT_V(n) asm volatile("s_waitcnt vmcnt(" #n ")" ::: "memory")
#define PG8_WAIT_L(n) asm volatile("s_waitcnt lgkmcnt(" #n ")" ::: "memory")
#define PG8_BAR __builtin_amdgcn_s_barrier()
#define PG8_SCHED __builtin_amdgcn_sched_barrier(0)
    Unit cur, nxt; int ui = 0;
    if (!S.next(0, cur)) return;
    f32x4 acc[2][2][4][2];
#pragma unroll
    for (int a = 0; a < 2; ++a)
#pragma unroll
        for (int b = 0; b < 2; ++b)
#pragma unroll
            for (int m = 0; m < 4; ++m)
#pragma unroll
                for (int n = 0; n < 2; ++n) acc[a][b][m][n] = (f32x4){0.f, 0.f, 0.f, 0.f};
    bf16x8 At[4][2], B0[2][2], B1[2][2];
    const char* cA = (const char*)g.A + (size_t)cur.pm * tstep; const char* cB = (const char*)g.Bt + (size_t)cur.pn * tstep;
    S.a_ready(cur);
    if constexpr (SP2) {
        PG8_STAGE(PG8_SB(0, 0), cB, voffB); PG8_STAGE(PG8_SB(0, 1), cB + hstep, voffB); PG8_STAGE(PG8_SA(0, 0), cA, voffA); PG8_STAGE(PG8_SA(0, 1), cA + hstep, voffA);
        if (wr == 1) PG8_BAR;
        PG8_WAIT_V(2); PG8_BAR;
        PG8_STAGE(PG8_SB(1, 0), cB + kstep, voffB); PG8_STAGE(PG8_SA(1, 0), cA + kstep, voffA); PG8_STAGE(PG8_SB(1, 1), cB + hstep + kstep, voffB);
        PG8_WAIT_V(6); PG8_BAR;
    } else {
        PG8_STAGE(PG8_SB(0, 0), cB, voffB); PG8_STAGE(PG8_SA(0, 0), cA, voffA); PG8_STAGE(PG8_SB(0, 1), cB + hstep, voffB); PG8_STAGE(PG8_SA(0, 1), cA + hstep, voffA);
        if (wr == 1) PG8_BAR;
        PG8_WAIT_V(4); PG8_BAR;
        PG8_STAGE(PG8_SB(1, 0), cB + kstep, voffB); PG8_STAGE(PG8_SA(1, 0), cA + kstep, voffA); PG8_STAGE(PG8_SB(1, 1), cB + hstep + kstep, voffB);
        PG8_WAIT_V(6); PG8_BAR;
    }
    for (;;) {
        const bool has_next = S.next(ui + 1, nxt);
        const char* nA = has_next ? (const char*)g.A + (size_t)nxt.pm * tstep : cA; const char* nB = has_next ? (const char*)g.Bt + (size_t)nxt.pn * tstep : cB;
        for (int t = 0; t < nt; t += 2) {
            const bool last = (t == nt - 2);
            const char* a1 = cA + (size_t)(t + 1) * kstep;
            const char* a2 = last ? nA : cA + (size_t)(t + 2) * kstep; const char* b2 = last ? nB : cB + (size_t)(t + 2) * kstep;
            const char* a3 = a2 + kstep; const char* b3 = b2 + kstep;
            if (last && has_next) S.a_ready(nxt);
            if constexpr (SP2) {
            PG8_LDB(B0, 0, 0); PG8_LDB(B1, 0, 1); PG8_SCHED; PG8_LDA(At, 0, 0); PG8_STAGE(PG8_SA(1, 1), a1 + hstep, voffA);
            PG8_WAIT_V(8); PG8_WAIT_L(0); PG8_BAR; PG8_MMA(0, 0, At, B0); PG8_MMA(0, 1, At, B1); PG8_BAR; PG8_SCHED;
            PG8_LDA(At, 0, 1); PG8_STAGE(PG8_SB(0, 0), b2, voffB); PG8_STAGE(PG8_SB(0, 1), b2 + hstep, voffB); PG8_STAGE(PG8_SA(0, 0), a2, voffA);
            PG8_WAIT_V(8); PG8_WAIT_L(0); PG8_BAR; PG8_MMA(1, 0, At, B0); PG8_MMA(1, 1, At, B1); PG8_BAR; PG8_SCHED;
            PG8_LDB(B0, 1, 0); PG8_LDB(B1, 1, 1); PG8_SCHED; PG8_LDA(At, 1, 0); PG8_STAGE(PG8_SA(0, 1), a2 + hstep, voffA);
            PG8_WAIT_V(8); PG8_WAIT_L(0); PG8_BAR; PG8_MMA(0, 0, At, B0); PG8_MMA(0, 1, At, B1); PG8_BAR; PG8_SCHED;
            PG8_LDA(At, 1, 1); PG8_STAGE(PG8_SB(1, 0), b3, voffB); PG8_STAGE(PG8_SB(1, 1), b3 + hstep, voffB); PG8_STAGE(PG8_SA(1, 0), a3, voffA);
            PG8_WAIT_V(8); PG8_WAIT_L(0); PG8_BAR; PG8_MMA(1, 0, At, B0); PG8_MMA(1, 1, At, B1); PG8_BAR; PG8_SCHED;
            } else {
            PG8_LDB(B0, 0, 0); PG8_SCHED; PG8_LDA(At, 0, 0); PG8_STAGE(PG8_SA(1, 1), a1 + hstep, voffA);
            PG8_WAIT_L(8); PG8_BAR; PG8_WAIT_L(0); PG8_MMA(0, 0, At, B0); PG8_BAR; PG8_SCHED;
            PG8_LDB(B1, 0, 1); PG8_STAGE(PG8_SB(0, 0), b2, voffB);
            PG8_BAR; PG8_WAIT_L(0); PG8_MMA(0, 1, At, B1); PG8_BAR;
            PG8_LDA(At, 0, 1); PG8_STAGE(PG8_SA(0, 0), a2, voffA);
            PG8_BAR; PG8_WAIT_L(0); PG8_MMA(1, 0, At, B0); PG8_BAR; PG8_SCHED;
            PG8_STAGE(PG8_SB(0, 1), b2 + hstep, voffB);
            PG8_WAIT_V(6); PG8_BAR; PG8_MMA(1, 1, At, B1); PG8_BAR;
            PG8_LDB(B0, 1, 0); PG8_SCHED; PG8_LDA(At, 1, 0); PG8_STAGE(PG8_SA(0, 1), a2 + hstep, voffA);
            PG8_WAIT_L(8); PG8_BAR; PG8_WAIT_L(0); PG8_MMA(0, 0, At, B0); PG8_BAR; PG8_SCHED;
            PG8_LDB(B1, 1, 1); PG8_STAGE(PG8_SB(1, 0), b3, voffB);
            PG8_BAR; PG8_WAIT_L(0); PG8_MMA(0, 1, At, B1); PG8_BAR;
            PG8_LDA(At, 1, 1); PG8_STAGE(PG8_SA(1, 0), a3, voffA);
            PG8_BAR; PG8_WAIT_L(0); PG8_MMA(1, 0, At, B0); PG8_BAR; PG8_SCHED;
            PG8_STAGE(PG8_SB(1, 1), b3 + hstep, voffB);
            PG8_WAIT_V(6); PG8_BAR; PG8_MMA(1, 1, At, B1); PG8_BAR;
            }
        }
        if constexpr (ALIGN_EPI) { if (wr == 0) PG8_BAR; }
        if constexpr (!Epi::AFTER_DRAIN) { E(acc, cur, wr, wc, fr, fq); S.done(cur); }
        if (!has_next) break;
#pragma unroll
        for (int a = 0; a < 2; ++a)
#pragma unroll
            for (int b = 0; b < 2; ++b)
#pragma unroll
                for (int m = 0; m < 4; ++m)
#pragma unroll
                    for (int n = 0; n < 2; ++n) acc[a][b][m][n] = (f32x4){0.f, 0.f, 0.f, 0.f};
        cur = nxt; cA = nA; cB = nB; ++ui;
        if constexpr (ALIGN_EPI) { if (wr == 1) PG8_BAR; }
    }
    PG8_WAIT_V(0);
    if constexpr (!ALIGN_EPI) { if (wr == 0) PG8_BAR; }
    PG8_BAR;
    if constexpr (Epi::AFTER_DRAIN) { E.fused(acc, cur, wr, wc, fr, fq, lds, wid, lane); S.done(cur); }
#undef PG8_SA
#undef PG8_SB
#undef PG8_STAGE
#undef PG8_LDA
#undef PG8_LDB
#undef PG8_MMA
#undef PG8_WAIT_V
#undef PG8_WAIT_L
#undef PG8_BAR
#undef PG8_SCHED
}
}

constexpr int NB = 8, SEQ = 2048, T = NB * SEQ, D = 2048, FF = 5632, NIN = 4352, NMOD = 9 * D;
constexpr float EPS = 1e-5f;
constexpr size_t MiB = 1u << 20;
constexpr size_t WS_WGU1 = 0, WS_WD1 = 44 * MiB, WS_WIN = 66 * MiB, WS_WOUT = 83 * MiB, WS_WGU2 = 91 * MiB, WS_WD2 = 135 * MiB;
constexpr size_t WS_MOD = 157 * MiB, WS_ROPE = 158 * MiB, WS_A = 159 * MiB, WS_R = 223 * MiB;
constexpr size_t WS_U = WS_R;
constexpr size_t WS_PROJ = WS_R, WS_OA = WS_R + 136 * MiB, WS_OB = WS_OA + 32 * MiB, WS_LSE = WS_OB + 96 * MiB, WS_CTL = WS_LSE + 3 * MiB, WS_XB = WS_CTL + 1 * MiB, WS_END = WS_XB + 64 * MiB;
constexpr int LDS_BYTES = 147456, NPH = 13;

#define LAS __attribute__((address_space(3)))
typedef unsigned short bf16;
typedef float f32x4 __attribute__((ext_vector_type(4)));
typedef float f32x16 __attribute__((ext_vector_type(16)));
typedef short bf16x8 __attribute__((ext_vector_type(8)));
typedef short s16x4 __attribute__((ext_vector_type(4)));
typedef unsigned u32x4 __attribute__((ext_vector_type(4)));
typedef unsigned u32x2 __attribute__((ext_vector_type(2)));
using pg8::cvt_pk_bf16;

__device__ __forceinline__ float wave_sum(float v) {
#pragma unroll
    for (int o = 1; o < 64; o <<= 1) v += __shfl_xor(v, o);
    return v;
}
__device__ __forceinline__ float bf_lo(unsigned w) { return __uint_as_float(w << 16); }
__device__ __forceinline__ float bf_hi(unsigned w) { return __uint_as_float(w & 0xffff0000u); }

struct Args { const float* in[20]; float* out; unsigned char* ws; float invf[8]; int ph_lo, ph_hi; };

struct TrItem { const float* W; bf16* WT; int K, N, mode, r; };
__device__ __forceinline__ void tr_load(const TrItem& t, f32x4 (&v)[16], int lane) {
    const int nblk = t.N / 64, kb = t.r / nblk, nb = t.r % nblk, k0 = 64 * kb, n0 = 64 * nb;
#pragma unroll
    for (int i = 0; i < 16; ++i) v[i] = __builtin_nontemporal_load((const f32x4*)(t.W + (size_t)(k0 + 4 * i + (lane >> 4)) * t.N + n0 + (lane & 15) * 4));
}
__device__ __forceinline__ void tr_lds_write(const f32x4 (&v)[16], LAS float* scr, int lane) {
#pragma unroll
    for (int i = 0; i < 16; ++i) { LAS float* s = scr + (4 * i + (lane >> 4)) * 65 + (lane & 15) * 4; s[0] = v[i][0]; s[1] = v[i][1]; s[2] = v[i][2]; s[3] = v[i][3]; }
}
__device__ __forceinline__ void tr_store(const TrItem& t, LAS float* scr, int lane) {
    const int nblk = t.N / 64, kb = t.r / nblk, nb = t.r % nblk, k0 = 64 * kb, n0 = 64 * nb;
    int drow0 = n0;
    if (t.mode == 1) { const int h = n0 >= FF ? 1 : 0, j = n0 - h * FF; drow0 = (j >> 7) * 256 + h * 128 + (j & 127); }
    const int c = lane & 7;
#pragma unroll
    for (int j = 0; j < 8; ++j) {
        const int n = (lane >> 3) + 8 * j; const LAS float* s = scr + (8 * c) * 65 + n;
        u32x4 o; o.x = cvt_pk_bf16(s[0], s[65]); o.y = cvt_pk_bf16(s[2 * 65], s[3 * 65]); o.z = cvt_pk_bf16(s[4 * 65], s[5 * 65]); o.w = cvt_pk_bf16(s[6 * 65], s[7 * 65]);
        *(u32x4*)(t.WT + (size_t)(drow0 + n) * t.K + k0 + 8 * c) = o;
    }
}
__device__ __forceinline__ void transpose_queue(const Args& a, LAS unsigned char* lds, int lane, int wave, int part) {
    unsigned char* ws = a.ws;
    LAS float* scr = (LAS float*)(lds + wave * 16640);
    unsigned* ctr = (unsigned*)(ws + WS_CTL) + 64 * part;
    constexpr int I_GU = (D / 64) * (2 * FF / 64), I_DN = (FF / 64) * (D / 64), I_IN = (D / 64) * (NIN / 64), I_OUT = (D / 64) * (D / 64);
    const int NITEMS = part == 0 ? I_GU + I_DN + I_IN + I_OUT : I_GU + I_DN;
    constexpr int CH = 8;
    static_assert(I_GU % CH == 0 && I_DN % CH == 0 && I_IN % CH == 0 && I_OUT % CH == 0, "chunks");
    auto decode = [&](int r) -> TrItem {
        if (part == 0) {
            if (r < I_GU) return TrItem{a.in[6], (bf16*)(ws + WS_WGU1), D, 2 * FF, 1, r}; r -= I_GU;
            if (r < I_DN) return TrItem{a.in[7], (bf16*)(ws + WS_WD1), FF, D, 0, r}; r -= I_DN;
            if (r < I_IN) return TrItem{a.in[9], (bf16*)(ws + WS_WIN), D, NIN, 0, r}; r -= I_IN;
            return TrItem{a.in[14], (bf16*)(ws + WS_WOUT), D, D, 0, r};
        }
        if (r < I_GU) return TrItem{a.in[17], (bf16*)(ws + WS_WGU2), D, 2 * FF, 1, r}; r -= I_GU;
        return TrItem{a.in[18], (bf16*)(ws + WS_WD2), FF, D, 0, r};
    };
    for (;;) {
        unsigned cidx = 0; if (lane == 0) cidx = atomicAdd(ctr, 1u);
        cidx = __builtin_amdgcn_readfirstlane(cidx);
        if (cidx * CH >= (unsigned)NITEMS) break;
        f32x4 v[16];
        TrItem cur = decode((int)cidx * CH);
        tr_load(cur, v, lane);
#pragma unroll
        for (int q = 0; q < CH; ++q) {
            tr_lds_write(v, scr, lane);
            TrItem nxt = cur;
            if (q + 1 < CH) { nxt = decode((int)cidx * CH + q + 1); tr_load(nxt, v, lane); }
            tr_store(cur, scr, lane);
            cur = nxt;
        }
    }
}

__device__ __forceinline__ void p0_prep(const Args& a, LAS unsigned char* lds, int tid, int lane, int wave, int G, int rep) {
    unsigned char* ws = a.ws;
    if (rep == 0) {
        const int* pos = (const int*)a.in[2]; float* tab = (float*)(ws + WS_ROPE);
        for (int tok = blockIdx.x * 512 + tid; tok < T; tok += G * 512) {
            const float pf = (float)pos[tok];
#pragma unroll
            for (int i = 0; i < 8; ++i) {
                const float ang = pf * a.invf[i];
                double rev = (double)ang * 0.15915494309189535; rev -= floor(rev);
                const float fr = (float)rev;
                tab[tok * 16 + i] = __builtin_amdgcn_cosf(fr); tab[tok * 16 + 8 + i] = __builtin_amdgcn_sinf(fr);
            }
        }
    }
    if (rep == 0) {
        LAS float* scT = (LAS float*)lds;
        LAS float* red = (LAS float*)(lds + 65536);
        const float* cc = a.in[1]; const float* Wa = a.in[3]; const float* ba = a.in[4]; float* mod = (float*)(ws + WS_MOD);
        for (int i = tid; i < NB * D; i += 512) { const int b = i / D, k = i % D; const float x = cc[i]; scT[k * 8 + b] = x / (1.0f + __expf(-x)); }
        __syncthreads();
        for (int it = blockIdx.x; it < NMOD / 64; it += G) {
            const int j = it * 64 + lane; const float* wp = Wa + (size_t)(wave * 256) * NMOD + j;
            float acc[8];
#pragma unroll
            for (int b = 0; b < 8; ++b) acc[b] = 0.f;
            for (int k0 = 0; k0 < 256; k0 += 32) {
                float w[32];
#pragma unroll
                for (int kk = 0; kk < 32; ++kk) w[kk] = __builtin_nontemporal_load(wp + (size_t)(k0 + kk) * NMOD);
#pragma unroll
                for (int kk = 0; kk < 32; ++kk) {
                    const LAS f32x4* sp = (const LAS f32x4*)(scT + (wave * 256 + k0 + kk) * 8);
                    const f32x4 s0 = sp[0], s1 = sp[1];
                    acc[0] += s0[0] * w[kk]; acc[1] += s0[1] * w[kk]; acc[2] += s0[2] * w[kk]; acc[3] += s0[3] * w[kk];
                    acc[4] += s1[0] * w[kk]; acc[5] += s1[1] * w[kk]; acc[6] += s1[2] * w[kk]; acc[7] += s1[3] * w[kk];
                }
            }
#pragma unroll
            for (int b = 0; b < 8; ++b) red[(wave * 8 + b) * 64 + lane] = acc[b];
            __syncthreads();
            { const int b = tid >> 6; float s = 0.f;
#pragma unroll
              for (int w = 0; w < 8; ++w) s += red[(w * 8 + b) * 64 + lane];
              mod[(size_t)b * NMOD + j] = s + ba[j]; }
            __syncthreads();
        }
    }
    __syncthreads();
    __syncthreads();
    transpose_queue(a, lds, lane, wave, 0);
}

template <bool IN_BF16>
__device__ __forceinline__ void norm_phase(const void* Xv, const float* g, const float* mod, int sub, bf16* outb, float* outf, int gw, int NGW, int lane) {
    for (int rb = gw; rb < T / 8; rb += NGW) {
        const int b = rb / (SEQ / 8);
        f32x4 A[8], S[8];
#pragma unroll
        for (int j = 0; j < 8; ++j) {
            const int c4 = (64 * j + lane) * 4;
            A[j] = *(const f32x4*)(g + c4);
            if (mod) { const float* mp = mod + (size_t)b * NMOD + (sub * 3) * D + c4; S[j] = *(const f32x4*)(mp); A[j] = A[j] * (*(const f32x4*)(mp + D) + 1.0f); }
            else S[j] = (f32x4){0.f, 0.f, 0.f, 0.f};
        }
        for (int r = 0; r < 8; ++r) {
            const size_t row = (size_t)rb * 8 + r;
            f32x4 v[8]; float ss = 0.f;
#pragma unroll
            for (int j = 0; j < 8; ++j) {
                if (IN_BF16) { const u32x2 w = *(const u32x2*)((const bf16*)Xv + row * D + (64 * j + lane) * 4); v[j] = (f32x4){bf_lo(w.x), bf_hi(w.x), bf_lo(w.y), bf_hi(w.y)}; }
                else v[j] = *(const f32x4*)((const float*)Xv + row * D + (64 * j + lane) * 4);
                ss += (v[j][0] * v[j][0] + v[j][1] * v[j][1]) + (v[j][2] * v[j][2] + v[j][3] * v[j][3]); }
            const float rstd = rsqrtf(wave_sum(ss) * (1.0f / D) + EPS);
#pragma unroll
            for (int j = 0; j < 8; ++j) {
                const f32x4 o = v[j] * rstd * A[j] + S[j];
                if (mod) { u32x2 w; w.x = cvt_pk_bf16(o[0], o[1]); w.y = cvt_pk_bf16(o[2], o[3]); *(u32x2*)(outb + row * D + (64 * j + lane) * 4) = w; }
                else *(f32x4*)(outf + row * D + (64 * j + lane) * 4) = o;
            }
        }
    }
}

__device__ __forceinline__ int att_off(int row, int ch) { const int a = (row >> 1) & 7, x = ((a & 1) << 2) | (a >> 1); return row * 128 + ((ch ^ x) << 4); }
__device__ __forceinline__ int crow(int r, int hi) { return (r & 3) + 8 * (r >> 2) + 4 * hi; }

struct AttUnit { int mode, type, head, dil, tok0, q0, qcol, kcol, vcol; };
__device__ __forceinline__ AttUnit att_decode_pair(int u) {
    AttUnit x; x.mode = 0; x.type = u >> 11; const int rem = u & 2047; x.head = rem & 15; const int qg = rem >> 4;
    x.dil = x.type <= 1 ? 1 : (x.type == 2 ? 4 : 16); const int nb = 16 / x.dil, seq = qg / nb, blk = qg % nb, b = seq / x.dil, rr = seq % x.dil;
    x.tok0 = b * SEQ + rr; x.q0 = blk * 128;
    x.qcol = 1280 + x.head * 64; x.kcol = 2304 + x.head * 64; x.vcol = 3328 + x.head * 64;
    return x;
}
__device__ __forceinline__ AttUnit att_decode_gqa(int g, int wave) {
    AttUnit x; x.mode = 1; x.type = 0; const int kvh = g & 1, qb = (g >> 1) & 63, b = g >> 7;
    x.head = 8 * kvh + wave; x.dil = 1; x.tok0 = b * SEQ; x.q0 = qb * 32;
    x.qcol = x.head * 64; x.kcol = 1024 + kvh * 64; x.vcol = 1152 + kvh * 64;
    return x;
}
__device__ __forceinline__ AttUnit att_decode_wide(int w) {
    AttUnit x; x.mode = 2; x.type = 1 + (w >> 10); const int rem = w & 1023; x.head = rem & 15; const int qg = rem >> 4;
    x.dil = x.type == 1 ? 1 : 4; const int nb = 8 / x.dil, seq = qg / nb, blk = qg % nb, b = seq / x.dil, rr = seq % x.dil;
    x.tok0 = b * SEQ + rr; x.q0 = blk * 256;
    x.qcol = 1280 + x.head * 64; x.kcol = 2304 + x.head * 64; x.vcol = 3328 + x.head * 64;
    return x;
}
__device__ __forceinline__ AttUnit att_unit_of(int it, int nG, int nW, int G, int half, int wave, int mapx, int mapy) {
    if (G == 256) {
        if (it < 4) { const int n = mapy * 4 + it; return att_decode_gqa((mapx << 7) | ((n >> 1) << 1) | (n & 1), wave); }
        if (it < 12) { const int n = mapy * 8 + (it - 4), ty = n & 1, r = n >> 1, head = r & 15, q = r >> 4; return att_decode_wide((ty << 10) | ((mapx * 8 + q) << 4) | head); }
        const int n = mapy * 4 + (it - 12), rr = n >> 3, hp = n & 7;
        return att_decode_pair(3 * 2048 + (mapx * 16 + rr) * 16 + 2 * hp + half);
    }
    if (it < nG) return att_decode_gqa((int)blockIdx.x + it * G, wave);
    if (it < nG + nW) return att_decode_wide((int)blockIdx.x + (it - nG) * G);
    const int p = (int)blockIdx.x + (it - nG - nW) * G;
    return att_decode_pair(3 * 2048 + 2 * p + half);
}
__device__ __forceinline__ void att_issue(const bf16* P, const AttUnit& x, u32x4 (&kr)[8], u32x4 (&vr)[8], int tid, int htid) {
    const long vdelta = (long)(x.vcol - x.kcol) * 2;
    if (x.mode == 1) {
        const char* sb = (const char*)P + ((long)(x.tok0 + x.q0 - 128) * NIN + x.kcol) * 2;
        const unsigned voff = (unsigned)((tid >> 3) * NIN + (tid & 7) * 8) * 2u;
        const long istride = (long)64 * NIN * 2;
#pragma unroll
        for (int i = 0; i < 3; ++i) {
            if (i < 2 || tid < 256) { kr[i] = *(const u32x4*)(sb + i * istride + voff); vr[i] = *(const u32x4*)(sb + vdelta + i * istride + voff); }
            else { kr[i] = (u32x4){0u, 0u, 0u, 0u}; vr[i] = kr[i]; }
        }
#pragma unroll
        for (int i = 3; i < 8; ++i) { kr[i] = (u32x4){0u, 0u, 0u, 0u}; vr[i] = kr[i]; }
    } else if (x.mode == 2) {
        const char* sb = (const char*)P + ((long)(x.tok0 + (x.q0 - 128) * x.dil) * NIN + x.kcol) * 2;
        const unsigned voff = (unsigned)(((tid >> 3) * x.dil) * NIN + (tid & 7) * 8) * 2u;
        const long istride = (long)64 * x.dil * NIN * 2;
#pragma unroll
        for (int i = 0; i < 6; ++i) {
            if (i < 2 && x.q0 == 0) { kr[i] = (u32x4){0u, 0u, 0u, 0u}; vr[i] = kr[i]; }
            else { kr[i] = *(const u32x4*)(sb + i * istride + voff); vr[i] = *(const u32x4*)(sb + vdelta + i * istride + voff); }
        }
#pragma unroll
        for (int i = 6; i < 8; ++i) { kr[i] = (u32x4){0u, 0u, 0u, 0u}; vr[i] = kr[i]; }
    } else {
        const char* sb = (const char*)P + ((long)(x.tok0 + (x.q0 - 128) * x.dil) * NIN + x.kcol) * 2;
        const unsigned voff = (unsigned)(((htid >> 3) * x.dil) * NIN + (htid & 7) * 8) * 2u;
        const long istride = (long)32 * x.dil * NIN * 2;
        const bool skip4 = x.q0 == 0;
#pragma unroll
        for (int i = 0; i < 8; ++i) {
            if (i < 4 && skip4) { kr[i] = (u32x4){0u, 0u, 0u, 0u}; vr[i] = kr[i]; }
            else { kr[i] = *(const u32x4*)(sb + i * istride + voff); vr[i] = *(const u32x4*)(sb + vdelta + i * istride + voff); }
        }
    }
}
__device__ __forceinline__ void att_issue_q(const bf16* P, const AttUnit& x, bf16x8 (&qf)[4], int hw, int wave, int r32, int hi) {
    const int hwe = x.mode == 1 ? 0 : (x.mode == 2 ? wave : hw);
    const char* sq = (const char*)P + ((long)(x.tok0 + (x.q0 + 32 * hwe) * x.dil) * NIN + x.qcol) * 2;
    const unsigned qoff = (unsigned)((r32 * x.dil) * NIN + 8 * hi) * 2u;
#pragma unroll
    for (int s = 0; s < 4; ++s) qf[s] = *(const bf16x8*)(sq + 32 * s + qoff);
}

__device__ __forceinline__ void attn_phase(const Args& a, LAS unsigned char* lds, int tid, int lane, int wave, int G, int mapx, int mapy) {
    unsigned char* ws = a.ws;
    const bf16* P = (const bf16*)(ws + WS_PROJ);
    const int half = wave >> 2, hw = wave & 3, htid = tid & 255, r32 = lane & 31, hi = lane >> 5;
    LAS unsigned char* Kl = lds + half * 65536; LAS unsigned char* Vl = Kl + 32768;
    const float C2 = 0.125f * 1.4426950408889634f;
    const int blk16 = (lane >> 4) & 1, qq = (lane & 15) >> 2, pp = lane & 3;
    const int bx = (int)blockIdx.x;
    const int nG = bx < 1024 ? (1024 - 1 - bx) / G + 1 : 0, nW = bx < 2048 ? (2048 - 1 - bx) / G + 1 : 0, nP = bx < 1024 ? (1024 - 1 - bx) / G + 1 : 0, niter = nG + nW + nP;
    if (niter == 0) return;
    u32x4 kr[8], vr[8]; bf16x8 qn[4];
    AttUnit cur = att_unit_of(0, nG, nW, G, half, wave, mapx, mapy);
    att_issue(P, cur, kr, vr, tid, htid); att_issue_q(P, cur, qn, hw, wave, r32, hi);
    for (int it = 0; it < niter; ++it) {
        asm volatile("s_waitcnt lgkmcnt(0)\n\ts_barrier" ::: "memory");
        if (cur.mode == 1) {
#pragma unroll
            for (int i = 0; i < 3; ++i) { const int idx = i * 512 + tid, row = idx >> 3, ch = idx & 7; const int o = att_off(row, ch);
                if (i < 2 || tid < 256) { *(LAS u32x4*)(lds + o) = kr[i]; *(LAS u32x4*)(lds + 32768 + o) = vr[i]; } }
        } else if (cur.mode == 2) {
#pragma unroll
            for (int i = 0; i < 6; ++i) { const int idx = i * 512 + tid, row = idx >> 3, ch = idx & 7; const int o = att_off(row, ch); *(LAS u32x4*)(lds + o) = kr[i]; *(LAS u32x4*)(lds + 49152 + o) = vr[i]; }
        } else {
#pragma unroll
            for (int i = 0; i < 8; ++i) { const int idx = i * 256 + htid, row = idx >> 3, ch = idx & 7; const int o = att_off(row, ch); *(LAS u32x4*)(Kl + o) = kr[i]; *(LAS u32x4*)(Vl + o) = vr[i]; }
        }
        bf16x8 qf[4];
#pragma unroll
        for (int s = 0; s < 4; ++s) qf[s] = qn[s];
        asm volatile("s_waitcnt lgkmcnt(0)\n\ts_barrier" ::: "memory");
        const AttUnit x = cur;
        if (it + 1 < niter) { cur = att_unit_of(it + 1, nG, nW, G, half, wave, mapx, mapy); att_issue(P, cur, kr, vr, tid, htid); att_issue_q(P, cur, qn, hw, wave, r32, hi); }
        const int hwe = x.mode == 1 ? 0 : (x.mode == 2 ? wave : hw);
        LAS unsigned char* Kb = x.mode == 0 ? Kl : lds; LAS unsigned char* Vb = Kb + (x.mode == 2 ? 49152 : 32768);
        LAS unsigned char* kx[4]; LAS unsigned char* vx[2][2];
#pragma unroll
        for (int s = 0; s < 4; ++s) kx[s] = Kb + att_off(32 * hwe + r32, 2 * s + hi);
#pragma unroll
        for (int t = 0; t < 2; ++t)
#pragma unroll
            for (int c = 0; c < 2; ++c) vx[t][c] = Vb + att_off(32 * hwe + 4 * hi + qq + 8 * t, 4 * c + 2 * blk16 + (pp >> 1)) + 8 * (pp & 1);
        const int ql = 128 + 32 * hwe + r32;
        const int maxd = x.type == 0 ? 127 : 128;
        const float sink2 = x.type == 0 ? a.in[11][x.head] * 1.4426950408889634f : -INFINITY;
        float m = sink2, lsum = 0.f;
        f32x16 o[2]; o[0] = f32x16{}; o[1] = f32x16{};
#pragma unroll
        for (int ti = 4; ti >= 0; --ti) {
            const int tl = hwe + ti; const bool valid = (x.q0 - 128 + 32 * tl) >= 0;
            if (valid) {
                f32x16 acc = {};
#pragma unroll
                for (int s = 0; s < 4; ++s) { const bf16x8 kf = *(const LAS bf16x8*)(kx[s] + ti * 4096); acc = __builtin_amdgcn_mfma_f32_32x32x16_bf16(kf, qf[s], acc, 0, 0, 0); }
                float p[16]; float tmax = -INFINITY;
                if (ti == 4 || ti == 0) {
#pragma unroll
                    for (int r = 0; r < 16; ++r) { const int dd = ql - (32 * tl + crow(r, hi)); const bool ok = dd >= 0 && dd <= maxd; p[r] = ok ? acc[r] * C2 : -INFINITY; tmax = fmaxf(tmax, p[r]); }
                } else {
#pragma unroll
                    for (int r = 0; r < 16; ++r) { p[r] = acc[r] * C2; tmax = fmaxf(tmax, p[r]); }
                }
                tmax = fmaxf(tmax, __shfl_xor(tmax, 32));
                const float mnew = fmaxf(m, tmax);
                if (__any(mnew > m)) {
                    const float alpha = __builtin_amdgcn_exp2f(m - mnew);
                    lsum *= alpha;
#pragma unroll
                    for (int r = 0; r < 16; ++r) { o[0][r] *= alpha; o[1][r] *= alpha; }
                }
                m = mnew;
#pragma unroll
                for (int r = 0; r < 16; ++r) { p[r] = __builtin_amdgcn_exp2f(p[r] - mnew); lsum += p[r]; }
#pragma unroll
                for (int sp = 0; sp < 2; ++sp) {
                    u32x4 pw; pw.x = cvt_pk_bf16(p[8 * sp + 0], p[8 * sp + 1]); pw.y = cvt_pk_bf16(p[8 * sp + 2], p[8 * sp + 3]); pw.z = cvt_pk_bf16(p[8 * sp + 4], p[8 * sp + 5]); pw.w = cvt_pk_bf16(p[8 * sp + 6], p[8 * sp + 7]);
                    const bf16x8 pb = __builtin_bit_cast(bf16x8, pw);
#pragma unroll
                    for (int c = 0; c < 2; ++c) {
                        const s16x4 v0 = __builtin_bit_cast(s16x4, __builtin_amdgcn_ds_read_tr16_b64_v4i16((LAS s16x4*)(vx[0][c] + ti * 4096 + sp * 2048)));
                        const s16x4 v1 = __builtin_bit_cast(s16x4, __builtin_amdgcn_ds_read_tr16_b64_v4i16((LAS s16x4*)(vx[1][c] + ti * 4096 + sp * 2048)));
                        const bf16x8 vf = (bf16x8){v0[0], v0[1], v0[2], v0[3], v1[0], v1[1], v1[2], v1[3]};
                        o[c] = __builtin_amdgcn_mfma_f32_32x32x16_bf16(vf, pb, o[c], 0, 0, 0);
                    }
                }
            }
        }
        lsum += __shfl_xor(lsum, 32);
        if (x.type == 0) lsum += __builtin_amdgcn_exp2f(sink2 - m);
        const float inv = 1.0f / lsum;
        const size_t qtok = (size_t)(x.tok0 + (x.q0 + 32 * hwe + r32) * x.dil);
        bf16* outp = x.type == 0 ? (bf16*)(ws + WS_OA) : (bf16*)(ws + WS_OB) + (size_t)(x.type - 1) * T * 1024;
        bf16* op = outp + qtok * 1024 + x.head * 64 + 4 * hi;
#pragma unroll
        for (int c = 0; c < 2; ++c)
#pragma unroll
            for (int gq = 0; gq < 4; ++gq) { u32x2 w; w.x = cvt_pk_bf16(o[c][4 * gq] * inv, o[c][4 * gq + 1] * inv); w.y = cvt_pk_bf16(o[c][4 * gq + 2] * inv, o[c][4 * gq + 3] * inv); *(u32x2*)(op + 32 * c + 8 * gq) = w; }
        if (x.type != 0 && hi == 0) { float* lsep = (float*)(ws + WS_LSE) + (size_t)(x.type - 1) * T * 16; lsep[qtok * 16 + x.head] = (m + __log2f(lsum)) * 0.6931471805599453f; }
    }
}

__device__ __forceinline__ void combine_phase(const Args& a, int t0, int tstride, int tcnt, int lane) {
    unsigned char* ws = a.ws;
    const bf16* OA = (const bf16*)(ws + WS_OA); const bf16* OB = (const bf16*)(ws + WS_OB); const float* LSE = (const float*)(ws + WS_LSE); bf16* Y = (bf16*)(ws + WS_A);
    const float* ga = a.in[12] + 16 * lane; const float* gb = a.in[13] + 16 * lane;
    float GA[16], GB[16];
#pragma unroll
    for (int i = 0; i < 4; ++i) { const f32x4 x = *(const f32x4*)(ga + 4 * i), y = *(const f32x4*)(gb + 4 * i);
#pragma unroll
        for (int j = 0; j < 4; ++j) { GA[4 * i + j] = x[j]; GB[4 * i + j] = y[j]; } }
    for (int ti_ = 0; ti_ < tcnt; ++ti_) {
        const int tok = t0 + ti_ * tstride;
        float v[16];
        {
            const u32x4 w0 = *(const u32x4*)(OA + (size_t)tok * 1024 + 16 * lane), w1 = *(const u32x4*)(OA + (size_t)tok * 1024 + 16 * lane + 8);
#pragma unroll
            for (int i = 0; i < 4; ++i) { v[2 * i] = bf_lo(w0[i]); v[2 * i + 1] = bf_hi(w0[i]); v[8 + 2 * i] = bf_lo(w1[i]); v[8 + 2 * i + 1] = bf_hi(w1[i]); }
            float ss = 0.f;
#pragma unroll
            for (int i = 0; i < 16; ++i) ss += v[i] * v[i];
            const float rstd = rsqrtf(wave_sum(ss) * (1.0f / 1024.0f) + EPS);
            u32x4 o0, o1;
#pragma unroll
            for (int i = 0; i < 4; ++i) { o0[i] = cvt_pk_bf16(v[2 * i] * rstd * GA[2 * i], v[2 * i + 1] * rstd * GA[2 * i + 1]); o1[i] = cvt_pk_bf16(v[8 + 2 * i] * rstd * GA[8 + 2 * i], v[9 + 2 * i] * rstd * GA[9 + 2 * i]); }
            *(u32x4*)(Y + (size_t)tok * D + 16 * lane) = o0; *(u32x4*)(Y + (size_t)tok * D + 16 * lane + 8) = o1;
        }
        {
            const int h = lane >> 2;
            const float l0 = LSE[(size_t)tok * 16 + h], l1 = LSE[(size_t)T * 16 + (size_t)tok * 16 + h], l2 = LSE[(size_t)2 * T * 16 + (size_t)tok * 16 + h];
            const float m = fmaxf(l0, fmaxf(l1, l2)); float e0 = __expf(l0 - m), e1 = __expf(l1 - m), e2 = __expf(l2 - m); const float is = 1.0f / (e0 + e1 + e2);
            const float wgt[3] = {e0 * is, e1 * is, e2 * is};
#pragma unroll
            for (int i = 0; i < 16; ++i) v[i] = 0.f;
#pragma unroll
            for (int c = 0; c < 3; ++c) {
                const bf16* src = OB + (size_t)c * T * 1024 + (size_t)tok * 1024 + 16 * lane;
                const u32x4 w0 = *(const u32x4*)(src), w1 = *(const u32x4*)(src + 8);
#pragma unroll
                for (int i = 0; i < 4; ++i) { v[2 * i] += wgt[c] * bf_lo(w0[i]); v[2 * i + 1] += wgt[c] * bf_hi(w0[i]); v[8 + 2 * i] += wgt[c] * bf_lo(w1[i]); v[9 + 2 * i] += wgt[c] * bf_hi(w1[i]); }
            }
            float ss = 0.f;
#pragma unroll
            for (int i = 0; i < 16; ++i) ss += v[i] * v[i];
            const float rstd = rsqrtf(wave_sum(ss) * (1.0f / 1024.0f) + EPS);
            u32x4 o0, o1;
#pragma unroll
            for (int i = 0; i < 4; ++i) { o0[i] = cvt_pk_bf16(v[2 * i] * rstd * GB[2 * i], v[2 * i + 1] * rstd * GB[2 * i + 1]); o1[i] = cvt_pk_bf16(v[8 + 2 * i] * rstd * GB[8 + 2 * i], v[9 + 2 * i] * rstd * GB[9 + 2 * i]); }
            *(u32x4*)(Y + (size_t)tok * D + 1024 + 16 * lane) = o0; *(u32x4*)(Y + (size_t)tok * D + 1024 + 16 * lane + 8) = o1;
        }
    }
}

#define XB_TMO      128
#define XB_XCNT(j)  (256  + 64 * (j))
#define XB_XSUB(j)  (1280 + 64 * (j))
#define XB_XGEN(j)  (2304 + 64 * (j))
#define XB_TOP      3328
#define XB_TOPGEN   3392
#define XCD_BAR_WORDS 3456
#define XB_SPIN_CAP (1u << 24)

__device__ __forceinline__ unsigned xb_ld(unsigned* p)              { return __hip_atomic_load(p, __ATOMIC_RELAXED, __HIP_MEMORY_SCOPE_AGENT); }
__device__ __forceinline__ unsigned xb_add(unsigned* p, unsigned v) { return __hip_atomic_fetch_add(p, v, __ATOMIC_RELAXED, __HIP_MEMORY_SCOPE_AGENT); }
__device__ __forceinline__ unsigned xb_xcc_id() { return (unsigned)__builtin_amdgcn_s_getreg((3 << 11) | 20) & 0xFu; }
#define XB_SPIN(cond, bar) do { unsigned _sp = 0; while (cond) { __builtin_amdgcn_s_sleep(1); \
    if ((++_sp & 255u) == 0u) { if (xb_ld(&(bar)[XB_TMO])) break; if (_sp > XB_SPIN_CAP) { atomicAdd(&(bar)[XB_TMO], 1u); break; } } } } while (0)

struct XcdBarrier {
    unsigned* bar; unsigned x;
    volatile LAS unsigned* st;
};

__device__ __forceinline__ XcdBarrier xcd_barrier_post(unsigned* bar, volatile LAS unsigned* st) {
    XcdBarrier b; b.bar = bar; b.x = xb_xcc_id(); b.st = st;
    if (threadIdx.x == 0) st[3] = xb_add(&bar[XB_XCNT(b.x)], 1u);
    return b;
}
__device__ __forceinline__ void xcd_barrier_complete(unsigned* bar, unsigned x, unsigned& nloc, unsigned& nx) {
    const unsigned G = gridDim.x * gridDim.y * gridDim.z;
    unsigned sum, cnt, mine, sp = 0u;
    for (;;) {
        sum = 0u; cnt = 0u; mine = 0u;
#pragma unroll
        for (unsigned j = 0; j < 16; ++j) { const unsigned c = xb_ld(&bar[XB_XCNT(j)]); sum += c; cnt += (c > 0u) ? 1u : 0u; mine = (j == x) ? c : mine; }
        if (sum == G) break;
        __builtin_amdgcn_s_sleep(1);
        if ((++sp & 255u) == 0u) { if (xb_ld(&bar[XB_TMO])) break; if (sp > XB_SPIN_CAP) { atomicAdd(&bar[XB_TMO], 1u); break; } }
    }
    nloc = mine > 0u ? mine : 1u; nx = cnt > 0u ? cnt : 1u;
}

__device__ __forceinline__ void xcd_barrier(const XcdBarrier& b) {
    asm volatile("s_waitcnt vmcnt(0)" ::: "memory");
    __syncthreads();
    if (threadIdx.x == 0) {
        unsigned* bar = b.bar;
        __builtin_amdgcn_s_waitcnt(0);
        unsigned nloc = b.st[0], nx = b.st[1];
        if (nloc == 0u) { xcd_barrier_complete(bar, b.x, nloc, nx); b.st[0] = nloc; b.st[1] = nx; }
        const unsigned old = xb_add(&bar[XB_XSUB(b.x)], 1u);
        const unsigned gen = old / nloc;
        if (old + 1u == (gen + 1u) * nloc) {
            __builtin_amdgcn_fence(__ATOMIC_RELEASE, "agent");
            asm volatile("s_waitcnt vmcnt(0)" ::: "memory");
            const unsigned og = xb_add(&bar[XB_TOP], 1u);
            const unsigned tg = og / nx;
            if (og + 1u == (tg + 1u) * nx) xb_add(&bar[XB_TOPGEN], 1u);
            else XB_SPIN(xb_ld(&bar[XB_TOPGEN]) == tg, bar);
            __builtin_amdgcn_fence(__ATOMIC_ACQUIRE, "agent");
            xb_add(&bar[XB_XGEN(b.x)], 1u);
            asm volatile("s_waitcnt vmcnt(0)" ::: "memory");
        } else {
            XB_SPIN(xb_ld(&bar[XB_XGEN(b.x)]) == gen, bar);
            __builtin_amdgcn_fence(__ATOMIC_ACQUIRE, "agent");
            asm volatile("s_waitcnt vmcnt(0)" ::: "memory");
        }
    }
    __syncthreads();
}


__device__ __forceinline__ void xcd_barrier_local(const XcdBarrier& b) {
    asm volatile("s_waitcnt vmcnt(0)" ::: "memory");
    __syncthreads();
    if (threadIdx.x == 0) {
        unsigned* bar = b.bar;
        __builtin_amdgcn_s_waitcnt(0);
        const unsigned nloc = b.st[0];
        const unsigned old = xb_add(&bar[XB_XSUB(b.x)], 1u);
        const unsigned gen = old / nloc;
        if (old + 1u == (gen + 1u) * nloc) xb_add(&bar[XB_XGEN(b.x)], 1u);
        else XB_SPIN(xb_ld(&bar[XB_XGEN(b.x)]) == gen, bar);
        __builtin_amdgcn_fence(__ATOMIC_ACQUIRE, "agent");
        asm volatile("s_waitcnt vmcnt(0)" ::: "memory");
    }
    __syncthreads();
}

__global__ void __launch_bounds__(512, 2) mk_fwd(Args a) {
    extern __shared__ __attribute__((aligned(16))) unsigned char lds_raw[];
    LAS unsigned char* lds = (LAS unsigned char*)lds_raw;
    const int tid = threadIdx.x, lane = tid & 63, wave = __builtin_amdgcn_readfirstlane(tid >> 6);
    const int G = gridDim.x, gw = blockIdx.x * 8 + wave, NGW = G * 8;
    unsigned char* ws = a.ws;
    bf16* Abuf = (bf16*)(ws + WS_A); bf16* U = (bf16*)(ws + WS_U); bf16* XB = (bf16*)(ws + WS_XB); const float* mod = (const float*)(ws + WS_MOD);
#ifndef PHM
#define PHM 0xffff
#endif
#define HAS(k) ((PHM >> (k)) & 1)
    const int lo = a.ph_lo, hi = a.ph_hi;
    volatile LAS unsigned* MISC = (volatile LAS unsigned*)(lds + LDS_BYTES - 256);
    if (tid < 64) MISC[tid] = 0u;
    __syncthreads();
    XcdBarrier xbar; xbar.bar = (unsigned*)(ws + WS_CTL + 16384); xbar.x = 0; xbar.st = nullptr;
    if (hi - lo > 1) xbar = xcd_barrier_post((unsigned*)(ws + WS_CTL + 16384), MISC + 8);
#ifndef REPM
#define REPM 0
#endif
#define REP(k) (((REPM >> (k)) & 1) ? 2 : 1)
#define IN(k) (HAS(k) && lo <= (k) && (k) < hi)
    int mapx = (int)blockIdx.x & 7, mapy = (int)blockIdx.x >> 3; bool lok = false;
#define SEAM_LOCAL_MASK 0xDF6
#define SEAM(k) do { if ((k) + 1 < hi && lo <= (k)) { if (lok && ((SEAM_LOCAL_MASK >> (k)) & 1)) xcd_barrier_local(xbar); else xcd_barrier(xbar); } } while (0)
#define NORM_PH(k, BF, Xp, gp, sub) if (IN(k)) for (int rep_ = 0; rep_ < REP(k); ++rep_) { norm_phase<BF>(Xp, gp, mod, sub, Abuf, nullptr, gwm, NGW, lane); } SEAM(k)
#define SWIGLU_PH(k, WOFF) if (IN(k)) for (int rep_ = 0; rep_ < REP(k); ++rep_) { pg8::Gemm g{Abuf, (const bf16*)(ws + (WOFF)), T, 2 * FF, D}; pg8::StaticOrder S; S.init(T, 2 * FF, G, vc); \
        pg8::EpiSwiglu E{U, FF}; pg8::gemm_phase<pg8::EpiSwiglu, pg8::StaticOrder, GEMM_ALIGN, GEMM_SP2>(lds, g, S, E); } SEAM(k)
#define RESID_PH(k, BF, Ap, WOFF, KK, basep, biasp, sub, gs) if (IN(k)) for (int rep_ = 0; rep_ < REP(k); ++rep_) { pg8::Gemm g{Ap, (const bf16*)(ws + (WOFF)), T, D, KK}; pg8::StaticOrder S; S.init(T, D, G, vc); \
        pg8::EpiResid<BF> E{basep, XB, biasp, mod + ((sub) * 3 + 2) * D, gs, D, NMOD}; pg8::gemm_phase<pg8::EpiResid<BF>, pg8::StaticOrder, GEMM_ALIGN, GEMM_SP2>(lds, g, S, E); } SEAM(k)
    if (hi > 1000) cg::this_grid().sync();
    if (IN(0)) for (int rep_ = 0; rep_ < REP(0); ++rep_) { p0_prep(a, lds, tid, lane, wave, G, rep_); __syncthreads(); }
    SEAM(0);
    if (lo == 0 && hi > 1 && G == 256) {
        if (tid == 0) { unsigned okk = 1u; const unsigned* bw = xbar.bar;
#pragma unroll
            for (unsigned j = 0; j < 16; ++j) { const unsigned cnt = __hip_atomic_load(bw + XB_XCNT(j), __ATOMIC_RELAXED, __HIP_MEMORY_SCOPE_AGENT); okk &= (cnt == (j < 8 ? 32u : 0u)) ? 1u : 0u; }
            MISC[10] = okk; }
        __syncthreads();
        lok = MISC[10] != 0u;
        if (lok) { mapx = (int)xbar.x; mapy = (int)MISC[11]; }
    }
    const bool g256 = G == 256;
    const int vc = g256 ? mapy * 8 + mapx : (int)blockIdx.x;
    const int gwm = g256 ? mapx * 256 + mapy * 8 + wave : gw;
    NORM_PH(1, false, a.in[0], a.in[5], 0);
    SWIGLU_PH(2, WS_WGU1);
    RESID_PH(3, false, U, WS_WD1, FF, a.in[0], nullptr, 0, 0.5f);
    NORM_PH(4, true, XB, a.in[8], 1);
    if (IN(5)) for (int rep_ = 0; rep_ < REP(5); ++rep_) {
        pg8::Gemm g{Abuf, (const bf16*)(ws + WS_WIN), T, NIN, D}; pg8::StaticOrder S; S.init(T, NIN, G, vc);
        pg8::EpiQKV E{(bf16*)(ws + WS_PROJ), a.in[10], (const float*)(ws + WS_ROPE), NIN};
        pg8::gemm_phase<pg8::EpiQKV, pg8::StaticOrder, GEMM_ALIGN, GEMM_SP2>(lds, g, S, E);
        __syncthreads();
        transpose_queue(a, lds, lane, wave, 1);
    }
    SEAM(5);
    if (IN(6)) for (int rep_ = 0; rep_ < REP(6); ++rep_) attn_phase(a, lds, tid, lane, wave, G, mapx, mapy);
    SEAM(6);
    if (IN(7)) for (int rep_ = 0; rep_ < REP(7); ++rep_) combine_phase(a, g256 ? 2048 * mapx + mapy * 8 + wave : gw, g256 ? 256 : NGW, g256 ? 8 : (T - gw + NGW - 1) / NGW, lane);
    SEAM(7);
    RESID_PH(8, true, Abuf, WS_WOUT, D, XB, a.in[15], 1, 1.0f);
    NORM_PH(9, true, XB, a.in[16], 2);
    SWIGLU_PH(10, WS_WGU2);
    RESID_PH(11, true, U, WS_WD2, FF, XB, nullptr, 2, 0.5f);
    if (IN(12)) norm_phase<true>(XB, a.in[19], nullptr, 0, nullptr, a.out, gwm, NGW, lane);
}

extern "C" void kernel_launch(void* const* d_in, const int* in_sizes, int n_in, void* d_out, int out_size, void* d_ws, size_t ws_size, hipStream_t stream) {
    static int grid = 0;
    if (grid == 0) {
        if (n_in != 20 || in_sizes[0] != T * D || out_size != T * D || ws_size < WS_END) { fprintf(stderr, "kernel_launch: unexpected shapes / workspace (n_in %d, in0 %d, out %d, ws %zu < %zu)\n", n_in, n_in > 0 ? in_sizes[0] : -1, out_size, ws_size, (size_t)WS_END); grid = -1; return; }
        int dev = 0, cus = 0, per_cu = 0;
        if (hipGetDevice(&dev) != hipSuccess || hipDeviceGetAttribute(&cus, hipDeviceAttributeMultiprocessorCount, dev) != hipSuccess) { grid = -1; return; }
        if (hipFuncSetAttribute((const void*)mk_fwd, hipFuncAttributeMaxDynamicSharedMemorySize, LDS_BYTES) != hipSuccess) { fprintf(stderr, "kernel_launch: hipFuncSetAttribute failed\n"); grid = -1; return; }
        if (hipOccupancyMaxActiveBlocksPerMultiprocessor(&per_cu, (const void*)mk_fwd, 512, LDS_BYTES) != hipSuccess || per_cu < 1) { fprintf(stderr, "kernel_launch: occupancy query says %d\n", per_cu); per_cu = 1; }
        (void)hipGetLastError();
        grid = cus * per_cu;
    }
    if (grid < 0) return;
    (void)hipMemsetAsync((char*)d_ws + WS_CTL, 0, 65536, stream);
    Args a{};
    for (int i = 0; i < 20; ++i) a.in[i] = (const float*)d_in[i];
    a.out = (float*)d_out; a.ws = (unsigned char*)d_ws;
    for (int i = 0; i < 8; ++i) a.invf[i] = powf(500000.0f, -((float)(2 * i) / 16.0f));
#if MK_MULTI
#ifndef DBG_LAST
#define DBG_LAST (NPH - 1)
#endif
    for (int ph = 0; ph <= DBG_LAST; ++ph) {
#ifdef DBG_SKIP
        if ((DBG_SKIP >> ph) & 1) continue;
#endif
        a.ph_lo = ph; a.ph_hi = ph + 1; hipLaunchKernelGGL(mk_fwd, dim3(grid), dim3(512), LDS_BYTES, stream, a); }
#else
    a.ph_lo = 0; a.ph_hi = NPH;
    void* args[] = {&a};
    hipError_t e = hipLaunchCooperativeKernel((const void*)mk_fwd, dim3(grid), dim3(512), args, LDS_BYTES, stream);
    if (e != hipSuccess) fprintf(stderr, "cooperative launch failed: %s (grid %d)\n", hipGetErrorString(e), grid);
#endif
}
```
